# Optimizing an MI355X kernel written in HIP

```python
import jax, jax.numpy as jnp
from jax import lax
import numpy as np

D_MODEL = 2048
BATCH = 4
SEQ = 2048
DEPTH = 1

FOX_HEADS = 8
FOX_HEAD_DIM = 128
FOX_WIDTH = FOX_HEADS * FOX_HEAD_DIM
NSA_HEADS = 8
NSA_KV_GROUPS = 2
NSA_HPG = NSA_HEADS // NSA_KV_GROUPS
NSA_QK_DIM = 192
NSA_V_DIM = 128
NSA_WIDTH = NSA_HEADS * NSA_V_DIM
CMP_BLOCK = 32
CMP_STRIDE = 16
CMP_HIDDEN = 256
SEL_BLOCK = 64
SEL_TOPK = 16
SEL_LOCAL = 2
FORCE_SCORE = 1.0e4
WINDOW = 512
Q_BLOCK = 128
SEL_Q_CHUNK = 32
KV_K = NSA_KV_GROUPS * NSA_QK_DIM
KV_V = NSA_KV_GROUPS * NSA_V_DIM
D_FF = -(-(8 * D_MODEL) // (3 * 256)) * 256
RMS_EPS = 1e-6
IN_SPLITS = (FOX_WIDTH, FOX_WIDTH, FOX_WIDTH, FOX_HEADS,
             NSA_HEADS * NSA_QK_DIM, KV_K, KV_V, KV_K, KV_V, KV_K, KV_V,
             3 * NSA_HEADS, D_MODEL, D_MODEL)
D_IN = sum(IN_SPLITS)

kernel_name = "hybrid_fox_nsa_gated_parallel_block"


def _rms(x, gain):
    xf = x.astype(jnp.float32)
    y = xf * lax.rsqrt(jnp.mean(xf * xf, axis=-1, keepdims=True) + RMS_EPS)
    return (y * gain.astype(jnp.float32)).astype(x.dtype)


def _masked_softmax(s, mask):
    s = jnp.where(mask, s, -jnp.inf)
    m = jnp.max(s, axis=-1, keepdims=True)
    m = jnp.where(jnp.isfinite(m), m, 0.0)
    e = jnp.where(mask, jnp.exp(s - m), 0.0)
    return e / jnp.maximum(jnp.sum(e, axis=-1, keepdims=True), 1e-30)


def _alibi_slopes(n):
    return jnp.exp2(-8.0 * jnp.arange(1, n + 1, dtype=jnp.float32) / n)


def _fox_attention(q, k, v, log_f):
    B, T, H, Dh = q.shape
    nb = T // Q_BLOCK
    c = jnp.cumsum(log_f, axis=1).transpose(0, 2, 1)
    kh = k.transpose(0, 2, 1, 3)
    vh = v.transpose(0, 2, 1, 3)
    qb = q.reshape(B, nb, Q_BLOCK, H, Dh).transpose(1, 0, 3, 2, 4)
    cb = c.reshape(B, H, nb, Q_BLOCK).transpose(2, 0, 1, 3)
    scale = Dh ** -0.5
    kpos = jnp.arange(T)

    def block(args):
        qi, ci, i = args
        qpos = i * Q_BLOCK + jnp.arange(Q_BLOCK)
        s = jnp.einsum('bhqd,bhkd->bhqk', qi, kh, preferred_element_type=jnp.float32) * scale
        s = s + ci[..., :, None] - c[:, :, None, :]
        p = _masked_softmax(s, kpos[None, :] <= qpos[:, None])
        return jnp.einsum('bhqk,bhkd->bhqd', p.astype(vh.dtype), vh)

    o = lax.map(block, (qb, cb, jnp.arange(nb)))
    return o.transpose(1, 0, 3, 2, 4).reshape(B, T, H * Dh)


def _compress(z, pe, w1, w2):
    B, T, G, D = z.shape
    r = CMP_BLOCK // CMP_STRIDE
    ch = z.reshape(B, T // CMP_STRIDE, CMP_STRIDE, G, D)
    nc = T // CMP_STRIDE - r + 1
    blk = jnp.concatenate([ch[:, i:i + nc] for i in range(r)], axis=2)
    blk = blk + pe[None, None, :, None, :]
    flat = blk.transpose(0, 1, 3, 2, 4).reshape(B, nc, G, CMP_BLOCK * D)
    return jax.nn.silu(flat @ w1) @ w2


def _overlap_matrix(nc, ns):
    i = np.arange(nc)[:, None]
    j = np.arange(ns)[None, :]
    lo = np.maximum(i * CMP_STRIDE, j * SEL_BLOCK)
    hi = np.minimum(i * CMP_STRIDE + CMP_BLOCK, (j + 1) * SEL_BLOCK)
    return (np.maximum(hi - lo, 0) / CMP_STRIDE).astype(np.float32)


def _nsa_attention(q, kc_raw, vc_raw, ks_raw, vs_raw, kw_raw, vw_raw, gate_logits,
                   q_gain, kc_gain, ks_gain, kw_gain,
                   cmp_pe_k, cmp_w1_k, cmp_w2_k, cmp_pe_v, cmp_w1_v, cmp_w2_v):
    B, T, _ = q.shape
    G, HPG, Dk, Dv = NSA_KV_GROUPS, NSA_HPG, NSA_QK_DIM, NSA_V_DIM
    scale = Dk ** -0.5
    slopes = _alibi_slopes(NSA_HEADS).reshape(G, HPG)
    tpos = jnp.arange(T)
    qn = _rms(q.reshape(B, T, G, HPG, Dk), q_gain)
    qc = qn.transpose(0, 2, 3, 1, 4)

    kc = _rms(_compress(kc_raw.reshape(B, T, G, Dk), cmp_pe_k, cmp_w1_k, cmp_w2_k), kc_gain)
    vc = _compress(vc_raw.reshape(B, T, G, Dv), cmp_pe_v, cmp_w1_v, cmp_w2_v)
    nc = kc.shape[1]
    cend = jnp.arange(nc) * CMP_STRIDE + CMP_BLOCK - 1
    dist_c = tpos[:, None] - cend[None, :]
    s_c = jnp.einsum('btghd,bngd->bghtn', qn, kc, preferred_element_type=jnp.float32) * scale
    s_c = s_c - slopes[None, :, :, None, None] * dist_c.astype(jnp.float32)
    p_cmp = _masked_softmax(s_c, dist_c >= 0)
    o_cmp = jnp.einsum('bghtn,bngd->btghd', p_cmp.astype(vc.dtype), vc)

    ns = T // SEL_BLOCK
    n_sel = min(SEL_TOPK, ns)
    imp = jnp.einsum('bgtn,nj->bgtj', p_cmp.sum(axis=2), jnp.asarray(_overlap_matrix(nc, ns)))
    cur = tpos // SEL_BLOCK
    jidx = jnp.arange(ns)
    back = cur[:, None] - jidx[None, :]
    eligible = back >= 0
    forced = (jidx[None, :] == 0) | (eligible & (back < SEL_LOCAL))
    score = jnp.where(eligible, jnp.where(forced, FORCE_SCORE, imp), -1.0)
    top_score, idx = lax.top_k(score, n_sel)
    valid = top_score >= 0.0

    ks_b = _rms(ks_raw.reshape(B, T, G, Dk), ks_gain).transpose(0, 2, 1, 3).reshape(B, G, ns, SEL_BLOCK, Dk)
    vs_b = vs_raw.reshape(B, T, G, Dv).transpose(0, 2, 1, 3).reshape(B, G, ns, SEL_BLOCK, Dv)
    nq = T // SEL_Q_CHUNK
    q_ch = qc.reshape(B, G, HPG, nq, SEL_Q_CHUNK, Dk).transpose(3, 0, 1, 2, 4, 5)
    idx_ch = idx.reshape(B, G, nq, SEL_Q_CHUNK, n_sel).transpose(2, 0, 1, 3, 4)
    val_ch = valid.reshape(B, G, nq, SEL_Q_CHUNK, n_sel).transpose(2, 0, 1, 3, 4)
    bi = jnp.arange(B)[:, None, None, None]
    gi = jnp.arange(G)[None, :, None, None]
    in_blk = jnp.arange(SEL_BLOCK)

    def sel_chunk(args):
        qi, ii, vi, c = args
        kg = ks_b[bi, gi, ii]
        vg = vs_b[bi, gi, ii].reshape(B, G, SEL_Q_CHUNK, n_sel * SEL_BLOCK, Dv)
        qpos = c * SEL_Q_CHUNK + jnp.arange(SEL_Q_CHUNK)
        kpos = ii[..., None] * SEL_BLOCK + in_blk
        dist = qpos[None, None, :, None, None] - kpos
        mask = ((dist >= 0) & vi[..., None]).reshape(B, G, 1, SEL_Q_CHUNK, n_sel * SEL_BLOCK)
        s = jnp.einsum('bghqd,bgqskd->bghqsk', qi, kg, preferred_element_type=jnp.float32) * scale
        s = s - slopes[None, :, :, None, None, None] * dist[:, :, None].astype(jnp.float32)
        p = _masked_softmax(s.reshape(B, G, HPG, SEL_Q_CHUNK, n_sel * SEL_BLOCK), mask)
        return jnp.einsum('bghqk,bgqkd->bghqd', p.astype(vg.dtype), vg)

    o_slc = lax.map(sel_chunk, (q_ch, idx_ch, val_ch, jnp.arange(nq)))
    o_slc = o_slc.transpose(1, 0, 4, 2, 3, 5).reshape(B, T, G, HPG, Dv)

    nb = T // Q_BLOCK
    r = WINDOW // Q_BLOCK
    kw = _rms(kw_raw.reshape(B, T, G, Dk), kw_gain).transpose(0, 2, 1, 3)
    vw = vw_raw.reshape(B, T, G, Dv).transpose(0, 2, 1, 3)
    pad = ((0, 0), (0, 0), (WINDOW, 0), (0, 0))
    kwb = jnp.pad(kw, pad).reshape(B, G, nb + r, Q_BLOCK, Dk)
    vwb = jnp.pad(vw, pad).reshape(B, G, nb + r, Q_BLOCK, Dv)
    band_k = jnp.concatenate([kwb[:, :, i:i + nb] for i in range(r + 1)], axis=3)
    band_v = jnp.concatenate([vwb[:, :, i:i + nb] for i in range(r + 1)], axis=3)
    kb_len = (r + 1) * Q_BLOCK
    dist_w = jnp.arange(Q_BLOCK)[:, None] - jnp.arange(kb_len)[None, :] + WINDOW
    kpos_w = jnp.arange(nb)[:, None] * Q_BLOCK - WINDOW + jnp.arange(kb_len)[None, :]
    mask_w = (dist_w >= 0)[None] & (dist_w < WINDOW)[None] & (kpos_w >= 0)[:, None, :]
    q_w = qc.reshape(B, G, HPG, nb, Q_BLOCK, Dk)
    s_w = jnp.einsum('bghnqd,bgnkd->bghnqk', q_w, band_k, preferred_element_type=jnp.float32) * scale
    s_w = s_w - slopes[None, :, :, None, None, None] * dist_w.astype(jnp.float32)
    p_w = _masked_softmax(s_w, mask_w)
    o_win = jnp.einsum('bghnqk,bgnkd->bghnqd', p_w.astype(band_v.dtype), band_v)
    o_win = o_win.reshape(B, G, HPG, T, Dv).transpose(0, 3, 1, 2, 4)

    g = jax.nn.sigmoid(gate_logits.astype(jnp.float32)).reshape(B, T, G, HPG, 3)
    o = g[..., 0:1] * o_cmp + g[..., 1:2] * o_slc + g[..., 2:3] * o_win
    return o.reshape(B, T, NSA_WIDTH).astype(q.dtype)


def setup_inputs(seed: int = 0) -> dict:
    key = jax.random.key(seed)
    ks = jax.random.split(key, 24)
    f32 = jnp.float32
    L = DEPTH

    def nrm(k, shape, fan_in):
        return jax.random.normal(k, shape, f32) * fan_in ** -0.5

    def gain(k, shape):
        return 1.0 + 0.02 * jax.random.normal(k, shape, f32)

    return {
        "x": jax.random.normal(ks[0], (BATCH, SEQ, D_MODEL), f32),
        "norm_attn": gain(ks[1], (L, D_MODEL)),
        "w_in": nrm(ks[2], (L, D_MODEL, D_IN), D_MODEL),
        "fox_f_bias": 3.0 + 0.1 * jax.random.normal(ks[3], (L, FOX_HEADS), f32),
        "fox_q_gain": gain(ks[4], (L, FOX_HEAD_DIM)),
        "fox_k_gain": gain(ks[5], (L, FOX_HEAD_DIM)),
        "nsa_q_gain": gain(ks[6], (L, NSA_QK_DIM)),
        "nsa_kc_gain": gain(ks[7], (L, NSA_QK_DIM)),
        "nsa_ks_gain": gain(ks[8], (L, NSA_QK_DIM)),
        "nsa_kw_gain": gain(ks[9], (L, NSA_QK_DIM)),
        "cmp_pe_k": 0.02 * jax.random.normal(ks[10], (L, CMP_BLOCK, NSA_QK_DIM), f32),
        "cmp_w1_k": nrm(ks[11], (L, CMP_BLOCK * NSA_QK_DIM, CMP_HIDDEN), CMP_BLOCK * NSA_QK_DIM),
        "cmp_w2_k": nrm(ks[12], (L, CMP_HIDDEN, NSA_QK_DIM), CMP_HIDDEN),
        "cmp_pe_v": 0.02 * jax.random.normal(ks[13], (L, CMP_BLOCK, NSA_V_DIM), f32),
        "cmp_w1_v": nrm(ks[14], (L, CMP_BLOCK * NSA_V_DIM, CMP_HIDDEN), CMP_BLOCK * NSA_V_DIM),
        "cmp_w2_v": nrm(ks[15], (L, CMP_HIDDEN, NSA_V_DIM), CMP_HIDDEN),
        "w_up_fox": nrm(ks[16], (L, FOX_WIDTH, D_MODEL), FOX_WIDTH),
        "w_up_nsa": nrm(ks[17], (L, NSA_WIDTH, D_MODEL), NSA_WIDTH),
        "w_out": nrm(ks[18], (L, D_MODEL, D_MODEL), D_MODEL),
        "norm_ffn": gain(ks[19], (L, D_MODEL)),
        "w_ffn_gate": nrm(ks[20], (L, D_MODEL, D_FF), D_MODEL),
        "w_ffn_up": nrm(ks[21], (L, D_MODEL, D_FF), D_MODEL),
        "w_ffn_down": nrm(ks[22], (L, D_FF, D_MODEL), D_FF),
    }


def reference(x, norm_attn, w_in, fox_f_bias, fox_q_gain, fox_k_gain,
              nsa_q_gain, nsa_kc_gain, nsa_ks_gain, nsa_kw_gain,
              cmp_pe_k, cmp_w1_k, cmp_w2_k, cmp_pe_v, cmp_w1_v, cmp_w2_v,
              w_up_fox, w_up_nsa, w_out, norm_ffn, w_ffn_gate, w_ffn_up, w_ffn_down):
    B, T, _ = x.shape
    points = tuple(int(p) for p in np.cumsum(IN_SPLITS)[:-1])
    for l in range(DEPTH):
        xn = _rms(x, norm_attn[l])
        (fq, fk, fv, f_logit, nq, kc, vc, ksl, vsl, kw, vw,
         nsa_gate, gate_a, gate_b) = jnp.split(xn @ w_in[l], points, axis=-1)

        fq = _rms(fq.reshape(B, T, FOX_HEADS, FOX_HEAD_DIM), fox_q_gain[l])
        fk = _rms(fk.reshape(B, T, FOX_HEADS, FOX_HEAD_DIM), fox_k_gain[l])
        fv = fv.reshape(B, T, FOX_HEADS, FOX_HEAD_DIM)
        log_f = jax.nn.log_sigmoid(f_logit.astype(jnp.float32) + fox_f_bias[l].astype(jnp.float32))
        o_a = _fox_attention(fq, fk, fv, log_f)

        o_b = _nsa_attention(nq, kc, vc, ksl, vsl, kw, vw, nsa_gate,
                             nsa_q_gain[l], nsa_kc_gain[l], nsa_ks_gain[l], nsa_kw_gain[l],
                             cmp_pe_k[l], cmp_w1_k[l], cmp_w2_k[l],
                             cmp_pe_v[l], cmp_w1_v[l], cmp_w2_v[l])

        merged = (jax.nn.sigmoid(gate_a) * (o_a @ w_up_fox[l])
                  + jax.nn.sigmoid(gate_b) * (o_b @ w_up_nsa[l]))
        x = x + (merged @ w_out[l]).astype(x.dtype)

        hn = _rms(x, norm_ffn[l])
        x = x + ((jax.nn.silu(hn @ w_ffn_gate[l]) * (hn @ w_ffn_up[l])) @ w_ffn_down[l]).astype(x.dtype)
    return x
```

```cpp
#include <hip/hip_runtime.h>
#include <hip/hip_cooperative_groups.h>
#include <cstdio>
#include <cstdint>
#include <cmath>

#define LAS __attribute__((address_space(3)))
typedef unsigned short bf16;
typedef short bf16x8 __attribute__((ext_vector_type(8)));
typedef float f32x4 __attribute__((ext_vector_type(4)));
typedef unsigned u32x4 __attribute__((ext_vector_type(4)));
typedef unsigned u32x2 __attribute__((ext_vector_type(2)));

constexpr int BATCH = 4, SEQ = 2048, DM = 2048, MTOK = BATCH * SEQ;
constexpr int FH = 8, FD = 128;
constexpr int NHD = 8, NG = 2, HPG = 4, DK = 192, DV = 128;
constexpr int DFF = 5632, DIN = 10656, DINP = 10752, NGU = 2 * DFF;
constexpr int CROWS = 1024;
constexpr float EPS = 1e-6f;
constexpr int KS_K = 12, KS_V = 8, KSLICE = 512;

constexpr size_t MiB = 1u << 20;
constexpr size_t WS_CTL = 0;
constexpr size_t WS_SMALL = 1 * MiB;
constexpr size_t WS_CF = 2 * MiB;
constexpr size_t WS_KCC = WS_CF + 256 * 1024;
constexpr size_t WS_VCC = WS_KCC + 384 * 1024;
constexpr size_t WS_SUMSQ = WS_VCC + 256 * 1024;
constexpr size_t WS_BPK = WS_SUMSQ + 32 * 1024;
constexpr size_t WS_BPV = WS_BPK + 96 * 1024;
constexpr size_t WS_WU = 6 * MiB;
constexpr size_t WS_WOUT = 14 * MiB;
constexpr size_t WS_CW1K = 22 * MiB;
constexpr size_t WS_CW1V = 25 * MiB;
constexpr size_t WS_HSLK = 28 * MiB;
constexpr size_t WS_HSLV = 40 * MiB;
constexpr size_t WS_WIN = 48 * MiB;
constexpr size_t WS_XN = 90 * MiB;
constexpr size_t WS_WGU = 48 * MiB;
constexpr size_t WS_WD = 92 * MiB;
constexpr size_t WS_FQ = 122 * MiB, WS_FK = 138 * MiB, WS_FV = 154 * MiB;
constexpr size_t WS_NQ = 170 * MiB;
constexpr size_t WS_KC = 194 * MiB;
constexpr size_t WS_KS = 201 * MiB, WS_KW = 207 * MiB;
constexpr size_t WS_VC = 213 * MiB;
constexpr size_t WS_VS = 218 * MiB, WS_VW = 222 * MiB;
constexpr size_t WS_MERGED = 122 * MiB;
constexpr size_t WS_ACT = 122 * MiB;
constexpr size_t WS_GA = 226 * MiB, WS_GB = 258 * MiB;
constexpr size_t WS_HB = 226 * MiB;
constexpr size_t WS_OAB = 290 * MiB;
constexpr size_t WS_END = 322 * MiB;

__device__ __forceinline__ float bf2f(bf16 u) { return __uint_as_float((unsigned)u << 16); }
__device__ __forceinline__ unsigned f2bf(float f) { unsigned u = __float_as_uint(f); return (u + 0x7fffu + ((u >> 16) & 1u)) >> 16; }
__device__ __forceinline__ unsigned pk2(float lo, float hi) { return f2bf(lo) | (f2bf(hi) << 16); }
__device__ __forceinline__ float wsum(float v) {
#pragma unroll
    for (int o = 32; o > 0; o >>= 1) v += __shfl_xor(v, o);
    return v;
}
__device__ __forceinline__ float wmaxf(float v) {
#pragma unroll
    for (int o = 32; o > 0; o >>= 1) v = fmaxf(v, __shfl_xor(v, o));
    return v;
}
#define LDS_WAIT() asm volatile("s_waitcnt lgkmcnt(0)" ::: "memory")

namespace pg8 {
constexpr int BM = 256, BK = 64, HALF = 128, HTB = HALF * BK * 2, STAGE_BYTES = 8 * HTB, NXCD = 8, WGM = 8;
__host__ __device__ __forceinline__ int lds_byte(int r, int c) { const int st = (r >> 4) * 2 + (c >> 5), rr = r & 15, cc = c & 31, ob = rr * 64 + cc * 2; return st * 1024 + (ob ^ (((ob >> 9) & 1) << 5)); }
__host__ __device__ __forceinline__ void stage_rc(int b, int& R, int& C) { const int st = b / 1024, sb = b % 1024, swz = sb ^ (((sb >> 9) & 1) << 5); R = (st >> 1) * 16 + swz / 64; C = (st & 1) * 32 + (swz % 64) / 2; }
__host__ __device__ __forceinline__ int perm32(int rho) { const int n = rho >> 4, i = rho & 15; return 8 * (i >> 2) + 4 * n + (i & 3); }

struct Unit { int pm, pn, ks; };
struct Gemm { const bf16* A; const bf16* Bt; int lda, ldb, K; };

struct StaticOrder {
    int nM, nN, nwg, G, c;
    __host__ __device__ void init(int M, int N, int G_, int c_) { nM = M / BM; nN = N / BM; nwg = nM * nN; G = G_; c = c_; }
    __host__ __device__ bool next(int i, Unit& u) const {
        const long L = (long)i * G + c; if (L >= nwg) return false;
        int wgid = (int)L; { const int q = nwg / NXCD, r = nwg % NXCD, xcd = wgid % NXCD, off = wgid / NXCD; wgid = (xcd < r ? xcd * (q + 1) : r * (q + 1) + (xcd - r) * q) + off; }
        const int nig = WGM * nN, gid = wgid / nig, fm = gid * WGM, gsz = (nM - fm) < WGM ? (nM - fm) : WGM;
        u.pm = fm + ((wgid % nig) % gsz); u.pn = (wgid % nig) / gsz; u.ks = 0; return true;
    }
};
struct SplitOrder {
    int nM, nKS, G, c;
    __host__ __device__ bool next(int i, Unit& u) const { const long L = (long)i * G + c; if (L >= (long)nM * nKS) return false; u.pm = (int)(L % nM); u.pn = 0; u.ks = (int)(L / nM); return true; }
};

template <class Epi, class Sched, bool ALIGN_EPI>
__device__ __forceinline__ void gemm_phase(LAS unsigned char* lds, const Gemm g, const Sched& S, const Epi& E) {
    const int tid = threadIdx.x, wid = __builtin_amdgcn_readfirstlane(tid >> 6), lane = tid & 63, wr = wid >> 2, wc = wid & 3, fr = lane & 15, fq = lane >> 4;
    const int K = g.K, nt = K / BK;
    unsigned voffA[2], voffB[2];
#pragma unroll
    for (int i = 0; i < 2; ++i) { int R, C; stage_rc(tid * 16 + i * 8192, R, C); const int Rb = Epi::PERM ? ((R & ~31) + perm32(R & 31)) : R;
        voffA[i] = (unsigned)(R * g.lda + C) * 2u; voffB[i] = (unsigned)(Rb * g.ldb + C) * 2u; }
    const size_t kstep = (size_t)(BK * 2);
    const size_t hA = (size_t)HALF * g.lda * 2, hB = (size_t)HALF * g.ldb * 2;
    const unsigned ldsw = (unsigned)wid * 1024u;
    const int aoff = lds_byte(wr * 64 + fr, fq * 8), boff = lds_byte(wc * 32 + fr, fq * 8);
#define PG8_SA(b, h) (((b) * 2 + (h)) * HTB)
#define PG8_SB(b, h) ((4 + (b) * 2 + (h)) * HTB)
#define PG8_STAGE(bufoff, gbase, voff) do { _Pragma("unroll") for (int _i = 0; _i < 2; ++_i) \
        __builtin_amdgcn_global_load_lds((const unsigned*)((const char*)(gbase) + (voff)[_i]), (LAS unsigned*)(lds + (bufoff) + ldsw + _i * 8192), 16, 0, 0); } while (0)
#define PG8_LDA(dst, b, h) do { _Pragma("unroll") for (int m = 0; m < 4; ++m) _Pragma("unroll") for (int k = 0; k < 2; ++k) dst[m][k] = *(const LAS bf16x8*)(lds + PG8_SA(b, h) + aoff + m * 2048 + k * 1024); } while (0)
#define PG8_LDB(dst, b, h) do { _Pragma("unroll") for (int n = 0; n < 2; ++n) _Pragma("unroll") for (int k = 0; k < 2; ++k) dst[n][k] = *(const LAS bf16x8*)(lds + PG8_SB(b, h) + boff + n * 2048 + k * 1024); } while (0)
#define PG8_MMA(ai, bj, At, Bt) do { __builtin_amdgcn_s_setprio(1); _Pragma("unroll") for (int m = 0; m < 4; ++m) _Pragma("unroll") for (int n = 0; n < 2; ++n) _Pragma("unroll") for (int k = 0; k < 2; ++k) \
        acc[ai][bj][m][n] = __builtin_amdgcn_mfma_f32_16x16x32_bf16(Bt[n][k], At[m][k], acc[ai][bj][m][n], 0, 0, 0); __builtin_amdgcn_s_setprio(0); } while (0)
#define PG8_WAIT_V(n) asm volatile("s_waitcnt vmcnt(" #n ")" ::: "memory")
#define PG8_WAIT_L(n) asm volatile("s_waitcnt lgkmcnt(" #n ")" ::: "memory")
#define PG8_BAR __builtin_amdgcn_s_barrier()
#define PG8_SCHED __builtin_amdgcn_sched_barrier(0)
    Unit cur, nxt; int ui = 0;
    if (!S.next(0, cur)) return;
    f32x4 acc[2][2][4][2];
#pragma unroll
    for (int a = 0; a < 2; ++a)
#pragma unroll
        for (int b = 0; b < 2; ++b)
#pragma unroll
            for (int m = 0; m < 4; ++m)
#pragma unroll
                for (int n = 0; n < 2; ++n) acc[a][b][m][n] = (f32x4){0.f, 0.f, 0.f, 0.f};
    bf16x8 At[4][2], B0[2][2], B1[2][2];
    const char* cA = (const char*)g.A + ((size_t)cur.pm * BM * g.lda + (size_t)cur.ks * K) * 2;
    const char* cB = (const char*)g.Bt + ((size_t)cur.pn * BM * g.ldb + (size_t)cur.ks * K) * 2;
    PG8_STAGE(PG8_SB(0, 0), cB, voffB); PG8_STAGE(PG8_SB(0, 1), cB + hB, voffB); PG8_STAGE(PG8_SA(0, 0), cA, voffA); PG8_STAGE(PG8_SA(0, 1), cA + hA, voffA);
    if (wr == 1) PG8_BAR;
    PG8_WAIT_V(2); PG8_BAR;
    PG8_STAGE(PG8_SB(1, 0), cB + kstep, voffB); PG8_STAGE(PG8_SA(1, 0), cA + kstep, voffA); PG8_STAGE(PG8_SB(1, 1), cB + hB + kstep, voffB);
    PG8_WAIT_V(6); PG8_BAR;
    for (;;) {
        const bool has_next = S.next(ui + 1, nxt);
        const char* nA = has_next ? (const char*)g.A + ((size_t)nxt.pm * BM * g.lda + (size_t)nxt.ks * K) * 2 : cA;
        const char* nB = has_next ? (const char*)g.Bt + ((size_t)nxt.pn * BM * g.ldb + (size_t)nxt.ks * K) * 2 : cB;
        for (int t = 0; t < nt; t += 2) {
            const bool last = (t == nt - 2);
            const char* a1 = cA + (size_t)(t + 1) * kstep;
            const char* a2 = last ? nA : cA + (size_t)(t + 2) * kstep; const char* b2 = last ? nB : cB + (size_t)(t + 2) * kstep;
            const char* a3 = a2 + kstep; const char* b3 = b2 + kstep;
            PG8_LDB(B0, 0, 0); PG8_LDB(B1, 0, 1); PG8_SCHED; PG8_LDA(At, 0, 0); PG8_STAGE(PG8_SA(1, 1), a1 + hA, voffA);
            PG8_WAIT_V(8); PG8_WAIT_L(0); PG8_BAR; PG8_MMA(0, 0, At, B0); PG8_MMA(0, 1, At, B1); PG8_BAR; PG8_SCHED;
            PG8_LDA(At, 0, 1); PG8_STAGE(PG8_SB(0, 0), b2, voffB); PG8_STAGE(PG8_SB(0, 1), b2 + hB, voffB); PG8_STAGE(PG8_SA(0, 0), a2, voffA);
            PG8_WAIT_V(8); PG8_WAIT_L(0); PG8_BAR; PG8_MMA(1, 0, At, B0); PG8_MMA(1, 1, At, B1); PG8_BAR; PG8_SCHED;
            PG8_LDB(B0, 1, 0); PG8_LDB(B1, 1, 1); PG8_SCHED; PG8_LDA(At, 1, 0); PG8_STAGE(PG8_SA(0, 1), a2 + hA, voffA);
            PG8_WAIT_V(8); PG8_WAIT_L(0); PG8_BAR; PG8_MMA(0, 0, At, B0); PG8_MMA(0, 1, At, B1); PG8_BAR; PG8_SCHED;
            PG8_LDA(At, 1, 1); PG8_STAGE(PG8_SB(1, 0), b3, voffB); PG8_STAGE(PG8_SB(1, 1), b3 + hB, voffB); PG8_STAGE(PG8_SA(1, 0), a3, voffA);
            PG8_WAIT_V(8); PG8_WAIT_L(0); PG8_BAR; PG8_MMA(1, 0, At, B0); PG8_MMA(1, 1, At, B1); PG8_BAR; PG8_SCHED;
            if constexpr (Epi::HAS_MID) { if (t + 2 == (nt >> 1)) E.mid(acc, cur, wr, wc, fr, fq); }
        }
        if constexpr (ALIGN_EPI) { if (wr == 0) PG8_BAR; }
        E(acc, cur, wr, wc, fr, fq);
        if (!has_next) break;
#pragma unroll
        for (int a = 0; a < 2; ++a)
#pragma unroll
            for (int b = 0; b < 2; ++b)
#pragma unroll
                for (int m = 0; m < 4; ++m)
#pragma unroll
                    for (int n = 0; n < 2; ++n) acc[a][b][m][n] = (f32x4){0.f, 0.f, 0.f, 0.f};
        cur = nxt; cA = nA; cB = nB; ++ui;
        if constexpr (ALIGN_EPI) { if (wr == 1) PG8_BAR; }
    }
    PG8_WAIT_V(0);
    if constexpr (!ALIGN_EPI) { if (wr == 0) PG8_BAR; }
    PG8_BAR;
#undef PG8_SA
#undef PG8_SB
#undef PG8_STAGE
#undef PG8_LDA
#undef PG8_LDB
#undef PG8_MMA
#undef PG8_WAIT_V
#undef PG8_WAIT_L
#undef PG8_BAR
#undef PG8_SCHED
}
}

struct Params {
    const float* in[23];
    float* out;
    unsigned char* ws;
    int ph_lo, ph_hi;
};
enum { I_X = 0, I_NORM_ATTN, I_W_IN, I_FOX_F_BIAS, I_FOX_Q_GAIN, I_FOX_K_GAIN, I_NSA_Q_GAIN, I_NSA_KC_GAIN, I_NSA_KS_GAIN, I_NSA_KW_GAIN,
       I_PE_K, I_W1_K, I_W2_K, I_PE_V, I_W1_V, I_W2_V, I_W_UP_FOX, I_W_UP_NSA, I_W_OUT, I_NORM_FFN, I_W_GATE, I_W_UP, I_W_DOWN };

template <class F> struct EpiElem {
    static constexpr bool PERM = false, HAS_MID = false;
    F f;
    __device__ __forceinline__ void operator()(const f32x4 (&acc)[2][2][4][2], const pg8::Unit& u, int wr, int wc, int fr, int fq) const {
#pragma unroll
        for (int ai = 0; ai < 2; ++ai)
#pragma unroll
            for (int m = 0; m < 4; ++m) { const int row = u.pm * 256 + ai * 128 + wr * 64 + m * 16 + fr;
#pragma unroll
                for (int bj = 0; bj < 2; ++bj)
#pragma unroll
                    for (int n = 0; n < 2; ++n) { const int col = u.pn * 256 + bj * 128 + wc * 32 + n * 16 + fq * 4;
#pragma unroll
                        for (int e = 0; e < 4; ++e) f(row, col + e, acc[ai][bj][m][n][e]); } }
    }
};
struct EpiProj {
    static constexpr bool PERM = false, HAS_MID = false;
    unsigned char* ws;
    __device__ __forceinline__ void operator()(const f32x4 (&acc)[2][2][4][2], const pg8::Unit& u, int wr, int wc, int fr, int fq) const {
#pragma unroll
        for (int bj = 0; bj < 2; ++bj) {
            const int c0 = u.pn * 256 + bj * 128;
            int kind = 0, pitch = 0, coff = 0; size_t base = 0;
            if (c0 < 1024) { base = WS_FQ; pitch = 1024; coff = c0; }
            else if (c0 < 2048) { base = WS_FK; pitch = 1024; coff = c0 - 1024; }
            else if (c0 < 3072) { base = WS_FV; pitch = 1024; coff = c0 - 2048; }
            else if (c0 < 4608) { base = WS_NQ; pitch = 1536; coff = c0 - 3072; }
            else if (c0 < 4992) { kind = 1; coff = c0 - 4608; }
            else if (c0 < 5376) { base = WS_KS; pitch = 384; coff = c0 - 4992; }
            else if (c0 < 5760) { base = WS_KW; pitch = 384; coff = c0 - 5376; }
            else if (c0 < 6016) { kind = 2; coff = c0 - 5760; }
            else if (c0 < 6272) { base = WS_VS; pitch = 256; coff = c0 - 6016; }
            else if (c0 < 6528) { base = WS_VW; pitch = 256; coff = c0 - 6272; }
            else if (c0 < 8576) { base = WS_GA; pitch = 2048; coff = c0 - 6528; }
            else if (c0 < 10624) { base = WS_GB; pitch = 2048; coff = c0 - 8576; }
            else if (c0 < 10752 - 127) { kind = c0 == 10624 ? 3 : 4; }
            if (kind == 4) continue;
#pragma unroll
            for (int ai = 0; ai < 2; ++ai)
#pragma unroll
                for (int m = 0; m < 4; ++m) { const int row = u.pm * 256 + ai * 128 + wr * 64 + m * 16 + fr;
#pragma unroll
                    for (int n = 0; n < 2; ++n) { const int cw = wc * 32 + n * 16 + fq * 4; const f32x4 v = acc[ai][bj][m][n];
                        if (kind == 3) { if (cw < 32) *(f32x4*)((float*)(ws + WS_SMALL) + (size_t)row * 32 + cw) = v; continue; }
                        bf16* p;
                        if (kind == 0) p = (bf16*)(ws + base) + (size_t)row * pitch + coff + cw;
                        else if (kind == 1) { const int cc = coff + cw, g = cc >= 192 ? 1 : 0, d = cc - 192 * g; p = (bf16*)(ws + WS_KC) + ((size_t)(row + (row >> 11) * SEQ + g * SEQ)) * 192 + d; }
                        else { const int g = coff >> 7; p = (bf16*)(ws + WS_VC) + ((size_t)(row + (row >> 11) * SEQ + g * SEQ)) * 128 + cw; }
                        *(u32x2*)p = (u32x2){pk2(v[0], v[1]), pk2(v[2], v[3])}; } }
        }
    }
};
struct EpiSlab {
    static constexpr bool PERM = false, HAS_MID = false;
    float* slab;
    __device__ __forceinline__ void operator()(const f32x4 (&acc)[2][2][4][2], const pg8::Unit& u, int wr, int wc, int fr, int fq) const {
#pragma unroll
        for (int ai = 0; ai < 2; ++ai)
#pragma unroll
            for (int m = 0; m < 4; ++m) { const int row = u.pm * 256 + ai * 128 + wr * 64 + m * 16 + fr; float* rp = slab + ((size_t)u.ks * CROWS + row) * 256;
#pragma unroll
                for (int bj = 0; bj < 2; ++bj)
#pragma unroll
                    for (int n = 0; n < 2; ++n) *(f32x4*)(rp + bj * 128 + wc * 32 + n * 16 + fq * 4) = acc[ai][bj][m][n]; }
    }
};
__device__ __forceinline__ float clampf(float v, float lo, float hi) { return fminf(fmaxf(v, lo), hi); }
__device__ __forceinline__ float gl(unsigned w, int hi) { return clampf(__uint_as_float(hi ? (w & 0xffff0000u) : (w << 16)), -30.f, 30.f); }
struct EpiMerge {
    static constexpr bool PERM = false, HAS_MID = true;
    const bf16* GA; const bf16* GB; bf16* MG;
    __device__ __forceinline__ void mid(f32x4 (&acc)[2][2][4][2], const pg8::Unit& u, int wr, int wc, int fr, int fq) const {
        int zero; asm volatile("v_mov_b32 %0, 0" : "=v"(zero));
#pragma unroll
        for (int ai = 0; ai < 2; ++ai)
#pragma unroll
            for (int m = 0; m < 4; ++m) { const size_t row = u.pm * 256 + ai * 128 + wr * 64 + m * 16 + fr + zero;
#pragma unroll
                for (int bj = 0; bj < 2; ++bj)
#pragma unroll
                    for (int n = 0; n < 2; ++n) { const int col = u.pn * 256 + bj * 128 + wc * 32 + n * 16 + fq * 4;
                        const u32x2 ga = *(const u32x2*)(GA + row * 2048 + col), gb = *(const u32x2*)(GB + row * 2048 + col);
#pragma unroll
                        for (int e = 0; e < 4; ++e) { const float a = gl(e < 2 ? ga.x : ga.y, e & 1), b = gl(e < 2 ? gb.x : gb.y, e & 1);
                            acc[ai][bj][m][n][e] *= (1.f + __expf(-b)) * __builtin_amdgcn_rcpf(1.f + __expf(-a)); } }
                asm volatile("" ::: "memory"); }
    }
    __device__ __forceinline__ void operator()(const f32x4 (&acc)[2][2][4][2], const pg8::Unit& u, int wr, int wc, int fr, int fq) const {
#pragma unroll
        for (int ai = 0; ai < 2; ++ai)
#pragma unroll
            for (int m = 0; m < 4; ++m) { const size_t row = u.pm * 256 + ai * 128 + wr * 64 + m * 16 + fr;
#pragma unroll
                for (int bj = 0; bj < 2; ++bj)
#pragma unroll
                    for (int n = 0; n < 2; ++n) { const int col = u.pn * 256 + bj * 128 + wc * 32 + n * 16 + fq * 4;
                        const u32x2 gb = *(const u32x2*)(GB + row * 2048 + col); float o[4];
#pragma unroll
                        for (int e = 0; e < 4; ++e) { const float b = gl(e < 2 ? gb.x : gb.y, e & 1); o[e] = acc[ai][bj][m][n][e] * __builtin_amdgcn_rcpf(1.f + __expf(-b)); }
                        *(u32x2*)(MG + row * 2048 + col) = (u32x2){pk2(o[0], o[1]), pk2(o[2], o[3])}; }
                asm volatile("" ::: "memory"); }
    }
};
struct EpiOut {
    static constexpr bool PERM = false, HAS_MID = false;
    const float* x; float* out; bf16* HB; float* sumsq;
    __device__ __forceinline__ void operator()(const f32x4 (&acc)[2][2][4][2], const pg8::Unit& u, int wr, int wc, int fr, int fq) const {
#pragma unroll
        for (int ai = 0; ai < 2; ++ai)
#pragma unroll
            for (int m = 0; m < 4; ++m) { const size_t row = u.pm * 256 + ai * 128 + wr * 64 + m * 16 + fr; float ss = 0.f;
#pragma unroll
                for (int bj = 0; bj < 2; ++bj)
#pragma unroll
                    for (int n = 0; n < 2; ++n) { const int col = u.pn * 256 + bj * 128 + wc * 32 + n * 16 + fq * 4;
                        const f32x4 h = *(const f32x4*)(x + row * 2048 + col) + acc[ai][bj][m][n];
                        *(f32x4*)(out + row * 2048 + col) = h; ss += (h[0] * h[0] + h[1] * h[1]) + (h[2] * h[2] + h[3] * h[3]);
                        *(u32x2*)(HB + row * 2048 + col) = (u32x2){pk2(h[0], h[1]), pk2(h[2], h[3])}; }
                ss += __shfl_xor(ss, 16); ss += __shfl_xor(ss, 32);
                if (fq == 0) atomicAdd(sumsq + row, ss); }
    }
};
struct EpiFfn {
    static constexpr bool PERM = false, HAS_MID = false;
    const float* sumsq; bf16* ACT;
    __device__ __forceinline__ void operator()(const f32x4 (&acc)[2][2][4][2], const pg8::Unit& u, int wr, int wc, int fr, int fq) const {
#pragma unroll
        for (int ai = 0; ai < 2; ++ai)
#pragma unroll
            for (int m = 0; m < 4; ++m) { const size_t row = u.pm * 256 + ai * 128 + wr * 64 + m * 16 + fr;
                const float r = 1.0f / sqrtf(sumsq[row] * (1.0f / DM) + EPS);
#pragma unroll
                for (int n = 0; n < 2; ++n) { const int col = u.pn * 128 + wc * 32 + n * 16 + fq * 4; float o[4];
#pragma unroll
                    for (int e = 0; e < 4; ++e) { const float gg = acc[ai][0][m][n][e] * r, uu = acc[ai][1][m][n][e] * r; o[e] = gg / (1.f + __expf(-gg)) * uu; }
                    *(u32x2*)(ACT + row * DFF + col) = (u32x2){pk2(o[0], o[1]), pk2(o[2], o[3])}; } }
    }
};
struct EpiDown {
    static constexpr bool PERM = false, HAS_MID = false;
    float* out;
    __device__ __forceinline__ void operator()(const f32x4 (&acc)[2][2][4][2], const pg8::Unit& u, int wr, int wc, int fr, int fq) const {
#pragma unroll
        for (int ai = 0; ai < 2; ++ai)
#pragma unroll
            for (int m = 0; m < 4; ++m) { const size_t row = u.pm * 256 + ai * 128 + wr * 64 + m * 16 + fr;
#pragma unroll
                for (int bj = 0; bj < 2; ++bj)
#pragma unroll
                    for (int n = 0; n < 2; ++n) { float* p = out + row * 2048 + u.pn * 256 + bj * 128 + wc * 32 + n * 16 + fq * 4; *(f32x4*)p = *(const f32x4*)p + acc[ai][bj][m][n]; } }
    }
};

__device__ __forceinline__ int win_src(int n) {
    if (n < 3072) return n;
    if (n < 4608) return n + 8;
    if (n < 4992) return 4616 + (n - 4608);
    if (n < 5376) return 5256 + (n - 4992);
    if (n < 5760) return 5896 + (n - 5376);
    if (n < 6016) return 5000 + (n - 5760);
    if (n < 6272) return 5640 + (n - 6016);
    if (n < 6528) return 6280 + (n - 6272);
    if (n < 8576) return 6560 + (n - 6528);
    if (n < 10624) return 8608 + (n - 8576);
    if (n < 10632) return 3072 + (n - 10624);
    if (n < 10656) return 6536 + (n - 10632);
    return -1;
}
template <int MAP> __device__ __forceinline__ void tr_item(const float* __restrict__ W, const float* __restrict__ W2, int Nsrc, bf16* WT, int ldT, int kdst, const float* __restrict__ gain,
                                                           int nbn, LAS float* scr, int item, int lane) {
    const int kb = item / nbn, nb = item - kb * nbn, k0 = 64 * kb, n0 = 32 * nb;
    const int nd = n0 + (lane & 31);
    const float* src = W; int col = nd;
    if (MAP == 1) col = win_src(nd);
    if (MAP == 2) { const int tile = nd >> 8, w = nd & 255; if (w < 128) col = tile * 128 + w; else { col = tile * 128 + w - 128; src = W2; } }
    if (MAP == 3) col = nd < Nsrc ? nd : -1;
#pragma unroll 8
    for (int i = 0; i < 32; ++i) { const int kk = 2 * i + (lane >> 5); float v = 0.f;
        if (col >= 0) { v = src[(size_t)(k0 + kk) * Nsrc + col]; if (gain) v *= gain[k0 + kk]; }
        scr[kk * 33 + (lane & 31)] = v; }
    LDS_WAIT();
    const int c = lane & 7;
#pragma unroll
    for (int j = 0; j < 4; ++j) { const int n = (lane >> 3) + 8 * j; const LAS float* s = scr + (8 * c) * 33 + n;
        u32x4 o; o.x = pk2(s[0 * 33], s[1 * 33]); o.y = pk2(s[2 * 33], s[3 * 33]); o.z = pk2(s[4 * 33], s[5 * 33]); o.w = pk2(s[6 * 33], s[7 * 33]);
        *(u32x4*)(WT + (size_t)(n0 + n) * ldT + kdst + k0 + 8 * c) = o; }
    LDS_WAIT();
}
__device__ __forceinline__ void xn_row(const float* xrow, const float* gain, bf16* orow, int lane) {
    const f32x4* xr = (const f32x4*)xrow + lane; const f32x4* gr = (const f32x4*)gain + lane;
    f32x4 v[8]; float s = 0.f;
#pragma unroll
    for (int j = 0; j < 8; ++j) { v[j] = xr[64 * j]; s += (v[j][0] * v[j][0] + v[j][1] * v[j][1]) + (v[j][2] * v[j][2] + v[j][3] * v[j][3]); }
    const float r = 1.0f / sqrtf(wsum(s) * (1.0f / DM) + EPS);
    unsigned long long* o8 = (unsigned long long*)orow + lane;
#pragma unroll
    for (int j = 0; j < 8; ++j) { const f32x4 g = gr[64 * j]; const f32x4 o = v[j] * r * g;
        o8[64 * j] = (unsigned long long)pk2(o[0], o[1]) | ((unsigned long long)pk2(o[2], o[3]) << 32); }
}

constexpr int LDS_BYTES = 147456;
constexpr int NWAVES = 8, NTHREADS = 512;

enum { PH_P0 = 0, PH_GEMM1, PH_P2A, PH_P2B, PH_ATTN, PH_MERGE, PH_OUT, PH_FFN, PH_DOWN, PH_N };

__device__ __forceinline__ void phase_p0(const Params& p, LAS unsigned char* lds, int gw, int NGW, int wave, int lane) {
    unsigned char* ws = p.ws;
    LAS float* scr = (LAS float*)(lds + wave * 16384);
    constexpr int I_WIN = 32 * (DINP / 32), I_WU = 16 * 64, I_WOUT = 32 * 64, I_C1K = 96 * 8, I_C1V = 64 * 8;
    constexpr int NIT = I_WIN + 2 * I_WU + I_WOUT + I_C1K + I_C1V;
    for (int it = gw; it < NIT; it += NGW) {
        int r = it;
        if (r < I_WIN) { tr_item<1>(p.in[I_W_IN], nullptr, DIN, (bf16*)(ws + WS_WIN), 2048, 0, nullptr, DINP / 32, scr, r, lane); continue; } r -= I_WIN;
        if (r < I_WU) { tr_item<0>(p.in[I_W_UP_FOX], nullptr, 2048, (bf16*)(ws + WS_WU), 2048, 0, nullptr, 64, scr, r, lane); continue; } r -= I_WU;
        if (r < I_WU) { tr_item<0>(p.in[I_W_UP_NSA], nullptr, 2048, (bf16*)(ws + WS_WU), 2048, 1024, nullptr, 64, scr, r, lane); continue; } r -= I_WU;
        if (r < I_WOUT) { tr_item<0>(p.in[I_W_OUT], nullptr, 2048, (bf16*)(ws + WS_WOUT), 2048, 0, nullptr, 64, scr, r, lane); continue; } r -= I_WOUT;
        if (r < I_C1K) { tr_item<0>(p.in[I_W1_K], nullptr, 256, (bf16*)(ws + WS_CW1K), 6144, 0, nullptr, 8, scr, r, lane); continue; } r -= I_C1K;
        tr_item<0>(p.in[I_W1_V], nullptr, 256, (bf16*)(ws + WS_CW1V), 4096, 0, nullptr, 8, scr, r, lane);
    }
    for (int m = gw; m < MTOK; m += NGW) xn_row(p.in[I_X] + (size_t)m * DM, p.in[I_NORM_ATTN], (bf16*)(ws + WS_XN) + (size_t)m * DM, lane);
    for (int s = gw; s < 96 + 64; s += NGW) {
        const bool isv = s >= 96; const int sl = isv ? s - 96 : s;
        const float* pe = p.in[isv ? I_PE_V : I_PE_K] + sl * 64; const float* w = p.in[isv ? I_W1_V : I_W1_K] + (size_t)sl * 64 * 256 + 4 * lane;
        f32x4 a = {0.f, 0.f, 0.f, 0.f};
        for (int kk = 0; kk < 64; ++kk) a += *(const f32x4*)(w + (size_t)kk * 256) * pe[kk];
        *(f32x4*)((float*)(ws + (isv ? WS_BPV : WS_BPK)) + sl * 256 + 4 * lane) = a;
    }
    for (int i = gw * 64 + lane; i < MTOK; i += NGW * 64) ((float*)(ws + WS_SUMSQ))[i] = 0.f;
}

__device__ __forceinline__ float log_sigmoid(float z) { return fminf(z, 0.f) - log1pf(__expf(-fabsf(z))); }

__device__ __forceinline__ void phase_p2a_misc(const Params& p, LAS unsigned char* lds, int gw, int NGW, int wave, int lane) {
    unsigned char* ws = p.ws;
    for (int task = gw; task < MTOK * 12; task += NGW) {
        const int row = task / 12, seg = task - row * 12;
        bf16* base; const float* gain; int n;
        if (seg < 8) { base = (bf16*)(ws + WS_FK) + (size_t)row * 1024 + seg * 128; gain = p.in[I_FOX_K_GAIN]; n = 128; }
        else if (seg < 10) { base = (bf16*)(ws + WS_KS) + (size_t)row * 384 + (seg - 8) * 192; gain = p.in[I_NSA_KS_GAIN]; n = 192; }
        else { base = (bf16*)(ws + WS_KW) + (size_t)row * 384 + (seg - 10) * 192; gain = p.in[I_NSA_KW_GAIN]; n = 192; }
        unsigned* b32 = (unsigned*)base;
        const unsigned w0 = b32[lane]; const bool has2 = (n == 192) && lane < 32; const unsigned w1 = has2 ? b32[64 + lane] : 0u;
        const float a0 = bf2f((bf16)(w0 & 0xffffu)), a1 = bf2f((bf16)(w0 >> 16)), c0 = bf2f((bf16)(w1 & 0xffffu)), c1 = bf2f((bf16)(w1 >> 16));
        const float r = 1.0f / sqrtf(wsum(a0 * a0 + a1 * a1 + c0 * c0 + c1 * c1) / (float)n + EPS);
        b32[lane] = pk2(a0 * r * gain[2 * lane], a1 * r * gain[2 * lane + 1]);
        if (has2) b32[64 + lane] = pk2(c0 * r * gain[128 + 2 * lane], c1 * r * gain[128 + 2 * lane + 1]);
    }
    for (int task = gw; task < BATCH * FH; task += NGW) {
        const int b = task / FH, h = task - b * FH; const float bias = p.in[I_FOX_F_BIAS][h];
        const float* sm = (const float*)(ws + WS_SMALL) + ((size_t)b * SEQ + 32 * lane) * 32 + h;
        float s = 0.f;
        for (int i = 0; i < 32; ++i) s += log_sigmoid(sm[(size_t)i * 32] + bias);
        float incl = s;
#pragma unroll
        for (int o = 1; o < 64; o <<= 1) { const float y = __shfl_up(incl, o); if (lane >= o) incl += y; }
        float run = incl - s;
        float* cf = (float*)(ws + WS_CF) + ((size_t)b * FH + h) * SEQ + 32 * lane;
        for (int i = 0; i < 32; ++i) { run += log_sigmoid(sm[(size_t)i * 32] + bias); cf[i] = run; }
    }
    LAS float* scr = (LAS float*)(lds + wave * 16384);
    constexpr int I_GU = 32 * (NGU / 32), I_D = (DFF / 64) * 64;
    for (int it = gw; it < I_GU + I_D; it += NGW) {
        if (it < I_GU) tr_item<2>(p.in[I_W_GATE], p.in[I_W_UP], DFF, (bf16*)(ws + WS_WGU), 2048, 0, p.in[I_NORM_FFN], NGU / 32, scr, it, lane);
        else tr_item<0>(p.in[I_W_DOWN], nullptr, 2048, (bf16*)(ws + WS_WD), DFF, 0, nullptr, 64, scr, it - I_GU, lane);
    }
}

__device__ __forceinline__ void cmp_finish_unit(const Params& p, LAS unsigned char* lds, int u, int tid) {
    unsigned char* ws = p.ws;
    const bool isv = u >= 128; const int r0 = (u & 127) * 8;
    const int nsl = isv ? KS_V : KS_K, nbp = isv ? 64 : 96, ncol = isv ? 128 : 192;
    const float* slab = (const float*)(ws + (isv ? WS_HSLV : WS_HSLK)); const float* bp = (const float*)(ws + (isv ? WS_BPV : WS_BPK));
    const float* w2 = p.in[isv ? I_W2_V : I_W2_K];
    LAS float* hid = (LAS float*)lds;
    LAS float* bias = hid + 8 * 256;
    LAS float* ob = bias + 256;
    if (tid < 256) { float s = 0.f; for (int i = 0; i < nbp; ++i) s += bp[i * 256 + tid]; bias[tid] = s; }
    __syncthreads();
    for (int idx = tid; idx < 8 * 256; idx += NTHREADS) { const int r = idx >> 8, n = idx & 255; float s = bias[n];
        for (int k = 0; k < nsl; ++k) s += slab[((size_t)k * CROWS + r0 + r) * 256 + n];
        hid[idx] = s / (1.f + __expf(-s)); }
    __syncthreads();
    const int c = tid & 255, rg = tid >> 8;
    float a[4] = {0.f, 0.f, 0.f, 0.f};
    if (c < ncol) {
        for (int n = 0; n < 256; ++n) { const float w = w2[(size_t)n * ncol + c];
#pragma unroll
            for (int r = 0; r < 4; ++r) a[r] += hid[(rg * 4 + r) * 256 + n] * w; }
        if (isv) {
#pragma unroll
            for (int r = 0; r < 4; ++r) ((bf16*)(ws + WS_VCC))[(size_t)(r0 + rg * 4 + r) * 128 + c] = (bf16)f2bf(a[r]);
        } else {
#pragma unroll
            for (int r = 0; r < 4; ++r) ob[(rg * 4 + r) * 192 + c] = a[r];
        }
    }
    __syncthreads();
    if (!isv) {
        const int w = tid >> 6, lane = tid & 63;
        const float v0 = ob[w * 192 + lane], v1 = ob[w * 192 + 64 + lane], v2 = ob[w * 192 + 128 + lane];
        const float r = 1.0f / sqrtf(wsum(v0 * v0 + v1 * v1 + v2 * v2) * (1.0f / 192.f) + EPS);
        const float* g = p.in[I_NSA_KC_GAIN]; bf16* o = (bf16*)(ws + WS_KCC) + (size_t)(r0 + w) * 192;
        o[lane] = (bf16)f2bf(v0 * r * g[lane]); o[64 + lane] = (bf16)f2bf(v1 * r * g[64 + lane]); o[128 + lane] = (bf16)f2bf(v2 * r * g[128 + lane]);
    }
    __syncthreads();
}

__global__ void __launch_bounds__(NTHREADS, 2) fwd(Params p) {
    extern __shared__ __attribute__((aligned(16))) unsigned char lds_raw[];
    LAS unsigned char* lds = (LAS unsigned char*)lds_raw;
    const int tid = threadIdx.x, lane = tid & 63, wave = __builtin_amdgcn_readfirstlane(tid >> 6);
    const int G = gridDim.x, bx = blockIdx.x;
    const int vcu = (G % 8 == 0) ? (bx % 8) * (G / 8) + bx / 8 : bx;
    const int gw = vcu * NWAVES + wave, NGW = G * NWAVES;
    unsigned char* ws = p.ws;
    const int lo = p.ph_lo, hi = p.ph_hi;
#ifndef ONLY_PHASE
#define ONLY_PHASE -1
#endif
#define IN(k) ((ONLY_PHASE < 0 || ONLY_PHASE == (k)) && lo <= (k) && (k) < hi)
    if (IN(PH_P0)) { phase_p0(p, lds, gw, NGW, wave, lane); }
    if (IN(PH_GEMM1)) {
        pg8::Gemm g{(const bf16*)(ws + WS_XN), (const bf16*)(ws + WS_WIN), 2048, 2048, 2048};
        pg8::StaticOrder S; S.init(MTOK, DINP, G, bx);
        EpiProj E{ws};
        pg8::gemm_phase<EpiProj, pg8::StaticOrder, true>(lds, g, S, E);
    }
    if (IN(PH_P2A)) {
        phase_p2a_misc(p, lds, gw, NGW, wave, lane);
        __syncthreads();
        { pg8::Gemm g{(const bf16*)(ws + WS_KC), (const bf16*)(ws + WS_CW1K), 3072, 6144, KSLICE}; pg8::SplitOrder S{4, KS_K, G, bx};
          EpiSlab E{(float*)(ws + WS_HSLK)}; pg8::gemm_phase<EpiSlab, pg8::SplitOrder, false>(lds, g, S, E); }
        { pg8::Gemm g{(const bf16*)(ws + WS_VC), (const bf16*)(ws + WS_CW1V), 2048, 4096, KSLICE}; pg8::SplitOrder S{4, KS_V, G, (bx + G / 2) % G};
          EpiSlab E{(float*)(ws + WS_HSLV)}; pg8::gemm_phase<EpiSlab, pg8::SplitOrder, false>(lds, g, S, E); }
    }
    if (IN(PH_P2B)) {
        for (int u = bx; u < 256; u += G) cmp_finish_unit(p, lds, u, tid);
    }
    if (IN(PH_MERGE)) {
        pg8::Gemm g{(const bf16*)(ws + WS_OAB), (const bf16*)(ws + WS_WU), 2048, 2048, 2048};
        pg8::StaticOrder S; S.init(MTOK, 2048, G, bx);
        EpiMerge E{(const bf16*)(ws + WS_GA), (const bf16*)(ws + WS_GB), (bf16*)(ws + WS_MERGED)};
        pg8::gemm_phase<EpiMerge, pg8::StaticOrder, false>(lds, g, S, E);
    }
    if (IN(PH_OUT)) {
        pg8::Gemm g{(const bf16*)(ws + WS_MERGED), (const bf16*)(ws + WS_WOUT), 2048, 2048, 2048};
        pg8::StaticOrder S; S.init(MTOK, 2048, G, bx);
        EpiOut E{p.in[I_X], p.out, (bf16*)(ws + WS_HB), (float*)(ws + WS_SUMSQ)};
        pg8::gemm_phase<EpiOut, pg8::StaticOrder, false>(lds, g, S, E);
    }
    if (IN(PH_FFN)) {
        pg8::Gemm g{(const bf16*)(ws + WS_HB), (const bf16*)(ws + WS_WGU), 2048, 2048, 2048};
        pg8::StaticOrder S; S.init(MTOK, NGU, G, bx);
        EpiFfn E{(const float*)(ws + WS_SUMSQ), (bf16*)(ws + WS_ACT)};
        pg8::gemm_phase<EpiFfn, pg8::StaticOrder, true>(lds, g, S, E);
    }
    if (IN(PH_DOWN)) {
        pg8::Gemm g{(const bf16*)(ws + WS_ACT), (const bf16*)(ws + WS_WD), DFF, DFF, DFF};
        pg8::StaticOrder S; S.init(MTOK, 2048, G, bx);
        EpiDown E{p.out};
        pg8::gemm_phase<EpiDown, pg8::StaticOrder, false>(lds, g, S, E);
    }
#undef IN
}

__device__ __forceinline__ float dot8(const float* q, const bf16* k) {
    const u32x4 v = *(const u32x4*)k;
    return q[0] * bf2f((bf16)(v.x & 0xffffu)) + q[1] * bf2f((bf16)(v.x >> 16)) + q[2] * bf2f((bf16)(v.y & 0xffffu)) + q[3] * bf2f((bf16)(v.y >> 16))
         + q[4] * bf2f((bf16)(v.z & 0xffffu)) + q[5] * bf2f((bf16)(v.z >> 16)) + q[6] * bf2f((bf16)(v.w & 0xffffu)) + q[7] * bf2f((bf16)(v.w >> 16));
}

__global__ void __launch_bounds__(256) slow_fox(Params p) {
    __shared__ float qs[4][128];
    __shared__ float ss[4][2048];
    unsigned char* ws = p.ws;
    const int w = threadIdx.x >> 6, lane = threadIdx.x & 63;
    const int task = blockIdx.x * 4 + w;
    const int t = task % SEQ, h = (task / SEQ) % FH, b = task / (SEQ * FH);
    const size_t row = (size_t)b * SEQ + t;
    const bf16* FQ = (const bf16*)(ws + WS_FQ); const bf16* FK = (const bf16*)(ws + WS_FK); const bf16* FV = (const bf16*)(ws + WS_FV);
    const float* gq = p.in[I_FOX_Q_GAIN];
    const float x0 = bf2f(FQ[row * 1024 + h * 128 + lane]), x1 = bf2f(FQ[row * 1024 + h * 128 + 64 + lane]);
    const float r = 1.0f / sqrtf(wsum(x0 * x0 + x1 * x1) * (1.0f / 128.f) + EPS);
    qs[w][lane] = x0 * r * gq[lane]; qs[w][lane + 64] = x1 * r * gq[lane + 64];
    __syncthreads();
    const float* cf = (const float*)(ws + WS_CF) + ((size_t)b * FH + h) * SEQ; const float ct = cf[t];
    float mx = -INFINITY;
    for (int j = lane; j <= t; j += 64) {
        const bf16* kp = FK + ((size_t)b * SEQ + j) * 1024 + h * 128; float d = 0.f;
        for (int i = 0; i < 128; i += 8) d += dot8(&qs[w][i], kp + i);
        const float s = d * 0.08838834764831845f + ct - cf[j]; ss[w][j] = s; mx = fmaxf(mx, s);
    }
    mx = wmaxf(mx); float sum = 0.f;
    for (int j = lane; j <= t; j += 64) { const float e = __expf(ss[w][j] - mx); ss[w][j] = e; sum += e; }
    sum = wsum(sum);
    __syncthreads();
    float o0 = 0.f, o1 = 0.f;
    for (int j = 0; j <= t; ++j) { const float pj = ss[w][j]; const bf16* vp = FV + ((size_t)b * SEQ + j) * 1024 + h * 128; o0 += pj * bf2f(vp[lane]); o1 += pj * bf2f(vp[lane + 64]); }
    const float inv = 1.f / sum;
    bf16* O = (bf16*)(ws + WS_OAB) + row * 2048 + h * 128;
    O[lane] = (bf16)f2bf(o0 * inv); O[lane + 64] = (bf16)f2bf(o1 * inv);
}

template <class KF> __device__ __forceinline__ void wave_attend(const float* q, int nk, KF kf, float* s, float& o0, float& o1, float& inv, int lane) {
    float mx = -INFINITY;
    for (int j = lane; j < nk; j += 64) { const bf16 *kp, *vp; float bias; bool ok; kf(j, kp, vp, bias, ok); float sc = -INFINITY;
        if (ok) { float d = 0.f; for (int i = 0; i < DK; i += 8) d += dot8(q + i, kp + i); sc = d * 0.07216878364870322f + bias; }
        s[j] = sc; mx = fmaxf(mx, sc); }
    mx = wmaxf(mx); if (mx == -INFINITY) mx = 0.f;
    float sum = 0.f;
    for (int j = lane; j < nk; j += 64) { const float sc = s[j]; const float e = (sc == -INFINITY) ? 0.f : __expf(sc - mx); s[j] = e; sum += e; }
    sum = wsum(sum);
    __syncthreads();
    o0 = 0.f; o1 = 0.f;
    for (int j = 0; j < nk; ++j) { const float pj = s[j]; if (pj != 0.f) { const bf16 *kp, *vp; float bias; bool ok; kf(j, kp, vp, bias, ok); o0 += pj * bf2f(vp[lane]); o1 += pj * bf2f(vp[lane + 64]); } }
    inv = sum > 0.f ? 1.f / sum : 0.f;
}

__global__ void __launch_bounds__(256) slow_nsa(Params p) {
    __shared__ float qs[4][192];
    __shared__ float ss[4][1024];
    __shared__ float pc[4][128];
    __shared__ int blk[16];
    __shared__ int nblk;
    unsigned char* ws = p.ws;
    const int w = threadIdx.x >> 6, lane = threadIdx.x & 63;
    const int t = blockIdx.x % SEQ, g = (blockIdx.x / SEQ) % NG, b = blockIdx.x / (SEQ * NG);
    const int h = g * HPG + w;
    const size_t row = (size_t)b * SEQ + t;
    const float slope = exp2f(-(float)(h + 1));
    const bf16* NQ = (const bf16*)(ws + WS_NQ) + row * 1536 + h * 192;
    const float* gq = p.in[I_NSA_Q_GAIN];
    { const float x0 = bf2f(NQ[lane]), x1 = bf2f(NQ[64 + lane]), x2 = bf2f(NQ[128 + lane]);
      const float r = 1.0f / sqrtf(wsum(x0 * x0 + x1 * x1 + x2 * x2) * (1.0f / 192.f) + EPS);
      qs[w][lane] = x0 * r * gq[lane]; qs[w][64 + lane] = x1 * r * gq[64 + lane]; qs[w][128 + lane] = x2 * r * gq[128 + lane]; }
    pc[w][lane] = 0.f; pc[w][64 + lane] = 0.f;
    __syncthreads();
    float acc0 = 0.f, acc1 = 0.f;
    const float* sm = (const float*)(ws + WS_SMALL) + row * 32 + 8 + h * 3;
    const float g0 = 1.f / (1.f + __expf(-sm[0])), g1 = 1.f / (1.f + __expf(-sm[1])), g2 = 1.f / (1.f + __expf(-sm[2]));
    const int nv = t >= 31 ? ((t - 31) / 16 + 1) : 0;
    {
        const bf16* KCC = (const bf16*)(ws + WS_KCC) + (size_t)((b * 2 + g) * 128) * 192; const bf16* VCC = (const bf16*)(ws + WS_VCC) + (size_t)((b * 2 + g) * 128) * 128;
        float o0, o1, inv;
        wave_attend(qs[w], nv, [&](int j, const bf16*& kp, const bf16*& vp, float& bias, bool& ok) { kp = KCC + (size_t)j * 192; vp = VCC + (size_t)j * 128; bias = -slope * (float)(t - (16 * j + 31)); ok = true; }, ss[w], o0, o1, inv, lane);
        for (int j = lane; j < nv; j += 64) pc[w][j] = ss[w][j] * inv;
        acc0 += g0 * o0 * inv; acc1 += g0 * o1 * inv;
    }
    __syncthreads();
    if (w == 0) {
        const int cur = t >> 6; float score = -1.f;
        if (lane < 32) { const int j = lane; float im = 0.f;
            for (int hh = 0; hh < 4; ++hh) { for (int n = 4 * j - 1; n <= 4 * j + 3; ++n) { if (n >= 0 && n < 127) im += pc[hh][n] * ((n == 4 * j - 1 || n == 4 * j + 3) ? 1.f : 2.f); } }
            const bool elig = j <= cur, forced = (j == 0) || (elig && (cur - j) < 2);
            score = elig ? (forced ? 1.0e4f : im) : -1.f; }
        int rank = 0;
        for (int j2 = 0; j2 < 32; ++j2) { const float s2 = __shfl(score, j2); if (s2 > score || (s2 == score && j2 < lane)) ++rank; }
        const bool sel = lane < 32 && rank < 16 && score >= 0.f;
        const unsigned long long m = __ballot(sel);
        if (sel) blk[__popcll(m & ((1ull << lane) - 1ull))] = lane;
        if (lane == 0) nblk = __popcll(m);
    }
    __syncthreads();
    {
        const int nb = nblk; const bf16* KS = (const bf16*)(ws + WS_KS) + g * 192; const bf16* VS = (const bf16*)(ws + WS_VS) + g * 128;
        float o0, o1, inv;
        wave_attend(qs[w], nb * 64, [&](int j, const bf16*& kp, const bf16*& vp, float& bias, bool& ok) { const int kpos = blk[j >> 6] * 64 + (j & 63);
            kp = KS + ((size_t)b * SEQ + kpos) * 384; vp = VS + ((size_t)b * SEQ + kpos) * 256; bias = -slope * (float)(t - kpos); ok = kpos <= t; }, ss[w], o0, o1, inv, lane);
        acc0 += g1 * o0 * inv; acc1 += g1 * o1 * inv;
    }
    __syncthreads();
    {
        const int k0 = t >= 511 ? t - 511 : 0; const bf16* KW = (const bf16*)(ws + WS_KW) + g * 192; const bf16* VW = (const bf16*)(ws + WS_VW) + g * 128;
        float o0, o1, inv;
        wave_attend(qs[w], t - k0 + 1, [&](int j, const bf16*& kp, const bf16*& vp, float& bias, bool& ok) { const int kpos = k0 + j;
            kp = KW + ((size_t)b * SEQ + kpos) * 384; vp = VW + ((size_t)b * SEQ + kpos) * 256; bias = -slope * (float)(t - kpos); ok = true; }, ss[w], o0, o1, inv, lane);
        acc0 += g2 * o0 * inv; acc1 += g2 * o1 * inv;
    }
    bf16* O = (bf16*)(ws + WS_OAB) + row * 2048 + 1024 + h * 128;
    O[lane] = (bf16)f2bf(acc0); O[lane + 64] = (bf16)f2bf(acc1);
}

extern "C" void kernel_launch(void* const* d_in, const int* in_sizes, int n_in, void* d_out, int out_size, void* d_ws, size_t ws_size, hipStream_t stream) {
    static int grid = 0;
    if (grid == 0) {
        if (n_in != 23 || out_size != MTOK * DM || ws_size < WS_END) { fprintf(stderr, "kernel_launch: unexpected shapes / workspace (%d inputs, out %d, ws %zu < %zu)\n", n_in, out_size, ws_size, (size_t)WS_END); grid = -1; return; }
        int dev = 0, cus = 0;
        if (hipGetDevice(&dev) != hipSuccess || hipDeviceGetAttribute(&cus, hipDeviceAttributeMultiprocessorCount, dev) != hipSuccess) { grid = -1; return; }
        if (hipFuncSetAttribute((const void*)fwd, hipFuncAttributeMaxDynamicSharedMemorySize, LDS_BYTES) != hipSuccess) { fprintf(stderr, "kernel_launch: hipFuncSetAttribute failed\n"); grid = -1; return; }
        grid = cus;
    }
    if (grid < 0) return;
    (void)hipMemsetAsync((char*)d_ws + WS_CTL, 0, 1 * MiB, stream);
    Params p{};
    for (int i = 0; i < 23; ++i) p.in[i] = (const float*)d_in[i];
    p.out = (float*)d_out; p.ws = (unsigned char*)d_ws;
    auto run = [&](int lo, int hi) { p.ph_lo = lo; p.ph_hi = hi; hipLaunchKernelGGL(fwd, dim3(grid), dim3(NTHREADS), LDS_BYTES, stream, p); };
    run(PH_P0, PH_P0 + 1);
    run(PH_GEMM1, PH_GEMM1 + 1);
    run(PH_P2A, PH_P2A + 1);
    run(PH_P2B, PH_P2B + 1);
    p.ph_lo = 0; p.ph_hi = 0;
    hipLaunchKernelGGL(slow_fox, dim3(BATCH * FH * SEQ / 4), dim3(256), 0, stream, p);
    hipLaunchKernelGGL(slow_nsa, dim3(BATCH * NG * SEQ), dim3(256), 0, stream, p);
    run(PH_MERGE, PH_MERGE + 1);
    run(PH_OUT, PH_OUT + 1);
    run(PH_FFN, PH_FFN + 1);
    run(PH_DOWN, PH_DOWN + 1);
}
```

```cpp
#include <hip/hip_runtime.h>
#include <hip/hip_cooperative_groups.h>
#include <cstdio>
#include <cstdint>
#include <cmath>

#define LAS __attribute__((address_space(3)))
typedef unsigned short bf16;
typedef short bf16x8 __attribute__((ext_vector_type(8)));
typedef float f32x4 __attribute__((ext_vector_type(4)));
typedef unsigned u32x4 __attribute__((ext_vector_type(4)));
typedef unsigned u32x2 __attribute__((ext_vector_type(2)));

constexpr int BATCH = 4, SEQ = 2048, DM = 2048, MTOK = BATCH * SEQ;
constexpr int FH = 8, FD = 128;
constexpr int NHD = 8, NG = 2, HPG = 4, DK = 192, DV = 128;
constexpr int DFF = 5632, DIN = 10656, DINP = 10752, NGU = 2 * DFF;
constexpr int CROWS = 1024;
constexpr float EPS = 1e-6f;
constexpr int KS_K = 12, KS_V = 8, KSLICE = 512;

constexpr size_t MiB = 1u << 20;
constexpr size_t WS_CTL = 0;
constexpr size_t WS_SMALL = 1 * MiB;
constexpr size_t WS_CF = 2 * MiB;
constexpr size_t WS_KCC = WS_CF + 256 * 1024;
constexpr size_t WS_VCC = WS_KCC + 384 * 1024;
constexpr size_t WS_SUMSQ = WS_VCC + 256 * 1024;
constexpr size_t WS_BPK = WS_SUMSQ + 32 * 1024;
constexpr size_t WS_BPV = WS_BPK + 96 * 1024;
constexpr size_t WS_BIAS = WS_BPV + 64 * 1024;
constexpr size_t WS_SSQ = 3 * MiB + 256 * 1024;
constexpr size_t WS_WU = 4 * MiB;
constexpr size_t WS_WOUT = 12 * MiB;
constexpr size_t WS_CW1K = 20 * MiB;
constexpr size_t WS_CW1V = 23 * MiB;
constexpr size_t WS_WGU = 25 * MiB;
constexpr size_t WS_WD = 69 * MiB;
constexpr size_t WS_WIN = 51 * MiB;
constexpr size_t WS_XN = 93 * MiB;
constexpr size_t WS_FQ = 125 * MiB, WS_FK = 141 * MiB, WS_FV = 157 * MiB;
constexpr size_t WS_NQ = 173 * MiB;
constexpr size_t WS_KC = 197 * MiB;
constexpr size_t WS_KS = 204 * MiB, WS_KW = 210 * MiB;
constexpr size_t WS_VC = 216 * MiB;
constexpr size_t WS_VS = 221 * MiB, WS_VW = 225 * MiB;
constexpr size_t WS_MERGED = 125 * MiB;
constexpr size_t WS_ACT = 125 * MiB;
constexpr size_t WS_GA = 229 * MiB, WS_GB = 261 * MiB;
constexpr size_t WS_HB = 229 * MiB;
constexpr size_t WS_OAB = 293 * MiB;
constexpr size_t WS_HSLK = 293 * MiB;
constexpr size_t WS_HSLV = 305 * MiB;
constexpr size_t WS_END = 325 * MiB;

static_assert(WS_WIN + (size_t)10240 * 4096 == WS_WD + (size_t)2048 * 5632 * 2 && WS_WGU + (size_t)11264 * 4096 == WS_WD, "FFN weight area ends where the surviving w_in rows begin");
__device__ __forceinline__ float bf2f(bf16 u) { return __uint_as_float((unsigned)u << 16); }
__device__ __forceinline__ unsigned f2bf(float f) { unsigned u = __float_as_uint(f); return (u + 0x7fffu + ((u >> 16) & 1u)) >> 16; }
__device__ __forceinline__ unsigned pk2(float lo, float hi) { return f2bf(lo) | (f2bf(hi) << 16); }
__device__ __forceinline__ float wsum(float v) {
#pragma unroll
    for (int o = 32; o > 0; o >>= 1) v += __shfl_xor(v, o);
    return v;
}
__device__ __forceinline__ float wmaxf(float v) {
#pragma unroll
    for (int o = 32; o > 0; o >>= 1) v = fmaxf(v, __shfl_xor(v, o));
    return v;
}
#define LDS_WAIT() asm volatile("s_waitcnt lgkmcnt(0)" ::: "memory")
__device__ __forceinline__ int lane_id() { int l; asm volatile("v_mbcnt_lo_u32_b32 %0, -1, 0\n\tv_mbcnt_hi_u32_b32 %0, -1, %0" : "=v"(l)); return l; }

namespace cg = cooperative_groups;
namespace pg8 {
constexpr int BM = 256, BK = 64, HALF = 128, HTB = HALF * BK * 2, STAGE_BYTES = 8 * HTB, NXCD = 8, WGM = 8;
__host__ __device__ __forceinline__ int lds_byte(int r, int c) { const int st = (r >> 4) * 2 + (c >> 5), rr = r & 15, cc = c & 31, ob = rr * 64 + cc * 2; return st * 1024 + (ob ^ (((ob >> 9) & 1) << 5)); }
__host__ __device__ __forceinline__ void stage_rc(int b, int& R, int& C) { const int st = b / 1024, sb = b % 1024, swz = sb ^ (((sb >> 9) & 1) << 5); R = (st >> 1) * 16 + swz / 64; C = (st & 1) * 32 + (swz % 64) / 2; }
__host__ __device__ __forceinline__ int perm32(int rho) { const int n = rho >> 4, i = rho & 15; return 8 * (i >> 2) + 4 * n + (i & 3); }

struct Unit { int pm, pn, ks; };
struct Gemm { const bf16* A; const bf16* Bt; int lda, ldb, K; };

struct StaticOrder {
    int nM, nN, nwg, G, c;
    __host__ __device__ void init(int M, int N, int G_, int c_) { nM = M / BM; nN = N / BM; nwg = nM * nN; G = G_; c = c_; }
    __host__ __device__ bool next(int i, Unit& u) const {
        const long L = (long)i * G + c; if (L >= nwg) return false;
        int wgid = (int)L; { const int q = nwg / NXCD, r = nwg % NXCD, xcd = wgid % NXCD, off = wgid / NXCD; wgid = (xcd < r ? xcd * (q + 1) : r * (q + 1) + (xcd - r) * q) + off; }
        const int nig = WGM * nN, gid = wgid / nig, fm = gid * WGM, gsz = (nM - fm) < WGM ? (nM - fm) : WGM;
        u.pm = fm + ((wgid % nig) % gsz); u.pn = (wgid % nig) / gsz; u.ks = 0; return true;
    }
    __device__ __forceinline__ void done(int) const {}
};
struct SplitOrder {
    int nM, nKS, G, c;
    __host__ __device__ bool next(int i, Unit& u) const { const long L = (long)i * G + c; if (L >= (long)nM * nKS) return false; u.pm = (int)(L % nM); u.pn = 0; u.ks = (int)(L / nM); return true; }
    __device__ __forceinline__ void done(int) const {}
};
struct Gemm1Order {
    StaticOrder so; int tail, tc, Gt;
    __device__ bool next(int i, Unit& u) const {
        if (!tail) return so.next(i, u);
        const long L = (long)i * Gt + tc; if (L >= 64) return false;
        u.pm = (int)(L >> 1); u.pn = 40 + (int)(L & 1); u.ks = 0; return true;
    }
    __device__ __forceinline__ void done(int) const {}
};

template <class Epi, class Sched, bool ALIGN_EPI>
__device__ __forceinline__ void gemm_phase(LAS unsigned char* lds, const Gemm g, const Sched& S, const Epi& E, int wid) {
    int lane_ = lane_id(); asm volatile("" : "+v"(lane_));
    const int lane = lane_, tid = wid * 64 + lane, wr = wid >> 2, wc = wid & 3, fr = lane & 15, fq = lane >> 4;
    const int K = g.K, nt = K / BK;
    unsigned voffA[2], voffB[2];
#pragma unroll
    for (int i = 0; i < 2; ++i) { int R, C; stage_rc(tid * 16 + i * 8192, R, C); const int Rb = Epi::PERM ? ((R & ~31) + perm32(R & 31)) : R;
        voffA[i] = (unsigned)(R * g.lda + C) * 2u; voffB[i] = (unsigned)(Rb * g.ldb + C) * 2u; }
    const size_t kstep = (size_t)(BK * 2);
    const size_t hA = (size_t)HALF * g.lda * 2, hB = (size_t)HALF * g.ldb * 2;
    const unsigned ldsw = (unsigned)wid * 1024u;
    const int aoff = lds_byte(wr * 64 + fr, fq * 8), boff = lds_byte(wc * 32 + fr, fq * 8);
#define PG8_SA(b, h) (((b) * 2 + (h)) * HTB)
#define PG8_SB(b, h) ((4 + (b) * 2 + (h)) * HTB)
#define PG8_STAGE(bufoff, gbase, voff) do { _Pragma("unroll") for (int _i = 0; _i < 2; ++_i) \
        __builtin_amdgcn_global_load_lds((const unsigned*)((const char*)(gbase) + (voff)[_i]), (LAS unsigned*)(lds + (bufoff) + ldsw + _i * 8192), 16, 0, 0); } while (0)
#define PG8_LDA(dst, b, h) do { _Pragma("unroll") for (int m = 0; m < 4; ++m) _Pragma("unroll") for (int k = 0; k < 2; ++k) dst[m][k] = *(const LAS bf16x8*)(lds + PG8_SA(b, h) + aoff + m * 2048 + k * 1024); } while (0)
#define PG8_LDB(dst, b, h) do { _Pragma("unroll") for (int n = 0; n < 2; ++n) _Pragma("unroll") for (int k = 0; k < 2; ++k) dst[n][k] = *(const LAS bf16x8*)(lds + PG8_SB(b, h) + boff + n * 2048 + k * 1024); } while (0)
#define PG8_MMA(ai, bj, At, Bt) do { __builtin_amdgcn_s_setprio(1); _Pragma("unroll") for (int m = 0; m < 4; ++m) _Pragma("unroll") for (int n = 0; n < 2; ++n) _Pragma("unroll") for (int k = 0; k < 2; ++k) \
        acc[ai][bj][m][n] = __builtin_amdgcn_mfma_f32_16x16x32_bf16(Bt[n][k], At[m][k], acc[ai][bj][m][n], 0, 0, 0); __builtin_amdgcn_s_setprio(0); } while (0)
#define PG8_WAIT_V(n) asm volatile("s_waitcnt vmcnt(" #n ")" ::: "memory")
#define PG8_WAIT_L(n) asm volatile("s_waitcnt lgkmcnt(" #n ")" ::: "memory")
#define PG8_BAR __builtin_amdgcn_s_barrier()
#define PG8_SCHED __builtin_amdgcn_sched_barrier(0)
    Unit cur, nxt; int ui = 0;
    if (!S.next(0, cur)) return;
    f32x4 acc[2][2][4][2];
#pragma unroll
    for (int a = 0; a < 2; ++a)
#pragma unroll
        for (int b = 0; b < 2; ++b)
#pragma unroll
            for (int m = 0; m < 4; ++m)
#pragma unroll
                for (int n = 0; n < 2; ++n) acc[a][b][m][n] = (f32x4){0.f, 0.f, 0.f, 0.f};
    bf16x8 At[4][2], B0[2][2], B1[2][2];
    const char* cA = (const char*)g.A + ((size_t)cur.pm * BM * g.lda + (size_t)cur.ks * K) * 2;
    const char* cB = (const char*)g.Bt + ((size_t)cur.pn * BM * g.ldb + (size_t)cur.ks * K) * 2;
    PG8_STAGE(PG8_SB(0, 0), cB, voffB); PG8_STAGE(PG8_SB(0, 1), cB + hB, voffB); PG8_STAGE(PG8_SA(0, 0), cA, voffA); PG8_STAGE(PG8_SA(0, 1), cA + hA, voffA);
    if (wr == 1) PG8_BAR;
    PG8_WAIT_V(2); PG8_BAR;
    PG8_STAGE(PG8_SB(1, 0), cB + kstep, voffB); PG8_STAGE(PG8_SA(1, 0), cA + kstep, voffA); PG8_STAGE(PG8_SB(1, 1), cB + hB + kstep, voffB);
    if constexpr (Epi::HAS_PREFETCH) E.prefetch(cur, wr, wc, fr, fq, lds + STAGE_BYTES + 1024 + wid * 1024);
    PG8_WAIT_V(6); PG8_BAR;
    for (;;) {
        const bool has_next = S.next(ui + 1, nxt);
        const char* nA = has_next ? (const char*)g.A + ((size_t)nxt.pm * BM * g.lda + (size_t)nxt.ks * K) * 2 : cA;
        const char* nB = has_next ? (const char*)g.Bt + ((size_t)nxt.pn * BM * g.ldb + (size_t)nxt.ks * K) * 2 : cB;
        for (int t = 0; t < nt; t += 2) {
            const bool last = (t == nt - 2);
            const char* a1 = cA + (size_t)(t + 1) * kstep;
            const char* a2 = last ? nA : cA + (size_t)(t + 2) * kstep; const char* b2 = last ? nB : cB + (size_t)(t + 2) * kstep;
            const char* a3 = a2 + kstep; const char* b3 = b2 + kstep;
            PG8_LDB(B0, 0, 0); PG8_LDB(B1, 0, 1); PG8_SCHED; PG8_LDA(At, 0, 0); PG8_STAGE(PG8_SA(1, 1), a1 + hA, voffA);
            PG8_WAIT_V(8); PG8_WAIT_L(0); PG8_BAR; PG8_MMA(0, 0, At, B0); PG8_MMA(0, 1, At, B1); PG8_BAR; PG8_SCHED;
            PG8_LDA(At, 0, 1); PG8_STAGE(PG8_SB(0, 0), b2, voffB); PG8_STAGE(PG8_SB(0, 1), b2 + hB, voffB); PG8_STAGE(PG8_SA(0, 0), a2, voffA);
            PG8_WAIT_V(8); PG8_WAIT_L(0); PG8_BAR; PG8_MMA(1, 0, At, B0); PG8_MMA(1, 1, At, B1); PG8_BAR; PG8_SCHED;
            PG8_LDB(B0, 1, 0); PG8_LDB(B1, 1, 1); PG8_SCHED; PG8_LDA(At, 1, 0); PG8_STAGE(PG8_SA(0, 1), a2 + hA, voffA);
            PG8_WAIT_V(8); PG8_WAIT_L(0); PG8_BAR; PG8_MMA(0, 0, At, B0); PG8_MMA(0, 1, At, B1); PG8_BAR; PG8_SCHED;
            PG8_LDA(At, 1, 1); PG8_STAGE(PG8_SB(1, 0), b3, voffB); PG8_STAGE(PG8_SB(1, 1), b3 + hB, voffB); PG8_STAGE(PG8_SA(1, 0), a3, voffA);
            PG8_WAIT_V(8); PG8_WAIT_L(0); PG8_BAR; PG8_MMA(1, 0, At, B0); PG8_MMA(1, 1, At, B1); PG8_BAR; PG8_SCHED;
            if constexpr (Epi::HAS_MID) { if (t + 2 == (nt >> 1)) E.mid(acc, cur, wr, wc, fr, fq); }
        }
        if constexpr (ALIGN_EPI) { if (wr == 0) PG8_BAR; }
        E(acc, cur, wr, wc, fr, fq);
        S.done(ui);
        if (!has_next) break;
#pragma unroll
        for (int a = 0; a < 2; ++a)
#pragma unroll
            for (int b = 0; b < 2; ++b)
#pragma unroll
                for (int m = 0; m < 4; ++m)
#pragma unroll
                    for (int n = 0; n < 2; ++n) acc[a][b][m][n] = (f32x4){0.f, 0.f, 0.f, 0.f};
        cur = nxt; cA = nA; cB = nB; ++ui;
        if constexpr (ALIGN_EPI) { if (wr == 1) PG8_BAR; }
    }
    PG8_WAIT_V(0);
    if constexpr (!ALIGN_EPI) { if (wr == 0) PG8_BAR; }
    PG8_BAR;
#undef PG8_SA
#undef PG8_SB
#undef PG8_STAGE
#undef PG8_LDA
#undef PG8_LDB
#undef PG8_MMA
#undef PG8_WAIT_V
#undef PG8_WAIT_L
#undef PG8_BAR
#undef PG8_SCHED
}
}


#define XB_TMO      128
#define XB_XCNT(j)  (256  + 64 * (j))
#define XB_XSUB(j)  (1280 + 64 * (j))
#define XB_XGEN(j)  (2304 + 64 * (j))
#define XB_TOP      3328
#define XB_TOPGEN   3392
#define XCD_BAR_WORDS 3456
#define XB_SPIN_CAP (1u << 18)
__device__ __forceinline__ unsigned xb_ld(unsigned* p)              { return __hip_atomic_load(p, __ATOMIC_RELAXED, __HIP_MEMORY_SCOPE_AGENT); }
__device__ __forceinline__ unsigned xb_add(unsigned* p, unsigned v) { return __hip_atomic_fetch_add(p, v, __ATOMIC_RELAXED, __HIP_MEMORY_SCOPE_AGENT); }
__device__ __forceinline__ unsigned xb_xcc_id() { return (unsigned)__builtin_amdgcn_s_getreg((3 << 11) | 20) & 0xFu; }
#define XB_SPIN(cond, bar) do { unsigned _sp = 0; while (cond) { __builtin_amdgcn_s_sleep(1); \
    if ((++_sp & 255u) == 0u) { if (xb_ld(&(bar)[XB_TMO])) break; if (_sp > XB_SPIN_CAP) { atomicAdd(&(bar)[XB_TMO], 1u); break; } } } } while (0)
struct XcdBarrier { unsigned* bar; unsigned x; volatile LAS unsigned* st; int wave; };
__device__ __forceinline__ XcdBarrier xcd_barrier_post(unsigned* bar, volatile LAS unsigned* st, int wave) {
    XcdBarrier b; b.bar = bar; b.x = xb_xcc_id(); b.st = st; b.wave = wave;
    if (wave == 0 && lane_id() == 0) (void)xb_add(&bar[XB_XCNT(b.x)], 1u);
    return b;
}
__device__ __forceinline__ void xcd_barrier_complete(unsigned* bar, unsigned x, unsigned& nloc, unsigned& nx) {
    const unsigned G = gridDim.x * gridDim.y * gridDim.z;
    unsigned sum, cnt, mine, sp = 0u;
    for (;;) {
        sum = 0u; cnt = 0u; mine = 0u;
#pragma unroll
        for (unsigned j = 0; j < 16; ++j) { const unsigned c = xb_ld(&bar[XB_XCNT(j)]); sum += c; cnt += (c > 0u) ? 1u : 0u; mine = (j == x) ? c : mine; }
        if (sum == G) break;
        __builtin_amdgcn_s_sleep(1);
        if ((++sp & 255u) == 0u) { if (xb_ld(&bar[XB_TMO])) break; if (sp > XB_SPIN_CAP) { atomicAdd(&bar[XB_TMO], 1u); break; } }
    }
    nloc = mine > 0u ? mine : 1u; nx = cnt > 0u ? cnt : 1u;
}
__device__ __forceinline__ void xcd_barrier(const XcdBarrier& b) {
    asm volatile("s_waitcnt vmcnt(0)" ::: "memory");
    __syncthreads();
    if (b.wave == 0 && lane_id() == 0) {
        unsigned* bar = b.bar;
        __builtin_amdgcn_s_waitcnt(0);
        unsigned nloc = b.st[0], nx = b.st[1];
        if (nloc == 0u) { xcd_barrier_complete(bar, b.x, nloc, nx); b.st[0] = nloc; b.st[1] = nx; }
        const unsigned old = xb_add(&bar[XB_XSUB(b.x)], 1u);
        const unsigned gen = old / nloc;
        if (old + 1u == (gen + 1u) * nloc) {
            __builtin_amdgcn_fence(__ATOMIC_RELEASE, "agent");
            asm volatile("s_waitcnt vmcnt(0)" ::: "memory");
            const unsigned og = xb_add(&bar[XB_TOP], 1u);
            const unsigned tg = og / nx;
            if (og + 1u == (tg + 1u) * nx) xb_add(&bar[XB_TOPGEN], 1u);
            else XB_SPIN(xb_ld(&bar[XB_TOPGEN]) == tg, bar);
            __builtin_amdgcn_fence(__ATOMIC_ACQUIRE, "agent");
            xb_add(&bar[XB_XGEN(b.x)], 1u);
            asm volatile("s_waitcnt vmcnt(0)" ::: "memory");
        } else {
            XB_SPIN(xb_ld(&bar[XB_XGEN(b.x)]) == gen, bar);
            __builtin_amdgcn_fence(__ATOMIC_ACQUIRE, "agent");
            asm volatile("s_waitcnt vmcnt(0)" ::: "memory");
        }
    }
    __syncthreads();
}

struct Params {
    const float* in[23];
    float* out;
    unsigned char* ws;
    int ph_lo, ph_hi;
};
enum { I_X = 0, I_NORM_ATTN, I_W_IN, I_FOX_F_BIAS, I_FOX_Q_GAIN, I_FOX_K_GAIN, I_NSA_Q_GAIN, I_NSA_KC_GAIN, I_NSA_KS_GAIN, I_NSA_KW_GAIN,
       I_PE_K, I_W1_K, I_W2_K, I_PE_V, I_W1_V, I_W2_V, I_W_UP_FOX, I_W_UP_NSA, I_W_OUT, I_NORM_FFN, I_W_GATE, I_W_UP, I_W_DOWN };

typedef float f32x2_t_ __attribute__((ext_vector_type(2))); typedef __bf16 bf16x2_t_ __attribute__((ext_vector_type(2)));
__device__ __forceinline__ unsigned cvtpk2(float lo, float hi) { f32x2_t_ v = {lo, hi}; bf16x2_t_ b = __builtin_convertvector(v, bf16x2_t_); return __builtin_bit_cast(unsigned, b); }
__device__ __forceinline__ u32x4 pack8(const f32x4& a, const f32x4& b) { return (u32x4){cvtpk2(a[0], a[1]), cvtpk2(a[2], a[3]), cvtpk2(b[0], b[1]), cvtpk2(b[2], b[3])}; }
struct EpiProj {
    static constexpr bool PERM = true, HAS_MID = false, HAS_PREFETCH = false;
    unsigned char* ws; const float* ksg; const float* kwg;
    __device__ __forceinline__ void operator()(const f32x4 (&acc)[2][2][4][2], const pg8::Unit& u, int wr, int wc, int fr, int fq) const {
#pragma unroll
        for (int bj = 0; bj < 2; ++bj) {
            const int c0 = u.pn * 256 + bj * 128;
            int kind = 0, pitch = 0, coff = 0; size_t base = 0;
            const float* kg = nullptr;
            int slot = -1;
            if (c0 < 1024) { base = WS_FQ; pitch = 1024; coff = c0; }
            else if (c0 < 2048) { base = WS_FK; pitch = 1024; coff = c0 - 1024; slot = coff >> 7; }
            else if (c0 < 3072) { base = WS_FV; pitch = 1024; coff = c0 - 2048; }
            else if (c0 < 4608) { base = WS_NQ; pitch = 1536; coff = c0 - 3072; }
            else if (c0 < 4992) { kind = 1; coff = c0 - 4608; }
            else if (c0 < 5376) { base = WS_KS; pitch = 384; coff = c0 - 4992; slot = 8 + ((coff + wc * 32) >= 192 ? 1 : 0); kg = ksg; }
            else if (c0 < 5760) { base = WS_KW; pitch = 384; coff = c0 - 5376; slot = 10 + ((coff + wc * 32) >= 192 ? 1 : 0); kg = kwg; }
            else if (c0 < 6016) { kind = 2; coff = c0 - 5760; }
            else if (c0 < 6272) { base = WS_VS; pitch = 256; coff = c0 - 6016; }
            else if (c0 < 6528) { base = WS_VW; pitch = 256; coff = c0 - 6272; }
            else if (c0 < 6656) { kind = 3; }
            else if (c0 < 8704) { base = WS_GA; pitch = 2048; coff = c0 - 6656; }
            else { base = WS_GB; pitch = 2048; coff = c0 - 8704; }
            const int cw = wc * 32 + fq * 8;
            f32x4 kg0 = {1.f, 1.f, 1.f, 1.f}, kg1 = {1.f, 1.f, 1.f, 1.f};
            if (kg) { const int d = (coff + cw) % 192; kg0 = *(const f32x4*)(kg + d); kg1 = *(const f32x4*)(kg + d + 4); }
#pragma unroll
            for (int ai = 0; ai < 2; ++ai)
#pragma unroll
                for (int m = 0; m < 4; ++m) { const int row = u.pm * 256 + ai * 128 + wr * 64 + m * 16 + fr;
                    f32x4 v0 = acc[ai][bj][m][0], v1 = acc[ai][bj][m][1];
                    if (slot >= 0) {
                        float ss = ((v0[0] * v0[0] + v0[1] * v0[1]) + (v0[2] * v0[2] + v0[3] * v0[3])) + ((v1[0] * v1[0] + v1[1] * v1[1]) + (v1[2] * v1[2] + v1[3] * v1[3]));
                        ss += __shfl_xor(ss, 16); ss += __shfl_xor(ss, 32);
                        if (fq == 0) atomicAdd((float*)(ws + WS_SSQ) + (size_t)slot * MTOK + row, ss); }
                    if (kg) { v0 *= kg0; v1 *= kg1; }
                    if (kind == 3) { if (cw < 32) { float* sp = (float*)(ws + WS_SMALL) + (size_t)row * 32 + cw; *(f32x4*)sp = v0; *(f32x4*)(sp + 4) = v1; } continue; }
                    bf16* p;
                    if (kind == 0) p = (bf16*)(ws + base) + (size_t)row * pitch + coff + cw;
                    else if (kind == 1) { const int cc = coff + cw, g = cc >= 192 ? 1 : 0, d = cc - 192 * g; p = (bf16*)(ws + WS_KC) + ((size_t)(row + (row >> 11) * SEQ + g * SEQ)) * 192 + d; }
                    else { const int g = coff >> 7; p = (bf16*)(ws + WS_VC) + ((size_t)(row + (row >> 11) * SEQ + g * SEQ)) * 128 + cw; }
                    if (c0 >= 6656) __builtin_nontemporal_store(pack8(v0, v1), (u32x4*)p); else *(u32x4*)p = pack8(v0, v1); }
        }
    }
};
struct EpiSlab {
    static constexpr bool PERM = true, HAS_MID = false, HAS_PREFETCH = false;
    float* slab;
    __device__ __forceinline__ void operator()(const f32x4 (&acc)[2][2][4][2], const pg8::Unit& u, int wr, int wc, int fr, int fq) const {
#pragma unroll
        for (int ai = 0; ai < 2; ++ai)
#pragma unroll
            for (int m = 0; m < 4; ++m) { const int row = u.pm * 256 + ai * 128 + wr * 64 + m * 16 + fr; float* rp = slab + ((size_t)u.ks * CROWS + row) * 256 + wc * 32 + fq * 8;
#pragma unroll
                for (int bj = 0; bj < 2; ++bj) { *(f32x4*)(rp + bj * 128) = acc[ai][bj][m][0]; *(f32x4*)(rp + bj * 128 + 4) = acc[ai][bj][m][1]; } }
    }
};
__device__ __forceinline__ float clampf(float v, float lo, float hi) { return fminf(fmaxf(v, lo), hi); }
__device__ __forceinline__ float gl(unsigned w, int hi) { return clampf(__uint_as_float(hi ? (w & 0xffff0000u) : (w << 16)), -30.f, 30.f); }
#define EPI_ROW(gi) ((size_t)(u.pm * 256 + ((gi) >> 2) * 128 + wr * 64 + ((gi) & 3) * 16 + fr))
#define EPI_FENCE() asm volatile("" ::: "memory")
#define EPI_PF(ptr) __builtin_amdgcn_global_load_lds((const unsigned*)(ptr), (LAS unsigned*)junk, 16, 0, 0)
struct EpiMerge {
    static constexpr bool PERM = true, HAS_MID = true, HAS_PREFETCH = false;
    const bf16* GA; const bf16* GB; bf16* MG;
    __device__ __forceinline__ void prefetch(const pg8::Unit& u, int wr, int wc, int fr, int fq, LAS unsigned char* junk) const {
        const size_t cbase = (size_t)(u.pn * 256 + wc * 32 + fq * 8);
#pragma unroll
        for (int gi = 0; gi < 8; ++gi) { const size_t o_ = EPI_ROW(gi) * 2048 + cbase; EPI_PF(GA + o_); EPI_PF(GA + o_ + 128); EPI_PF(GB + o_); EPI_PF(GB + o_ + 128); }
    }
    __device__ __forceinline__ void mid(f32x4 (&acc)[2][2][4][2], const pg8::Unit& u, int wr, int wc, int fr, int fq) const {
        int zero; asm volatile("v_mov_b32 %0, 0" : "=v"(zero));
        const size_t cbase = (size_t)(u.pn * 256 + wc * 32 + fq * 8 + zero);
#pragma unroll
        for (int hf = 0; hf < 2; ++hf) {
            u32x4 a[8], b[8];
#pragma unroll
            for (int i = 0; i < 8; ++i) { const int st = 8 * hf + i; const size_t o_ = EPI_ROW(st >> 1) * 2048 + cbase + (st & 1) * 128; a[i] = *(const u32x4*)(GA + o_); b[i] = *(const u32x4*)(GB + o_); }
#pragma unroll
            for (int i = 0; i < 8; ++i) { const int st = 8 * hf + i;
#pragma unroll
                for (int e = 0; e < 8; ++e) { const float ga_ = gl(a[i][e >> 1], e & 1), gb_ = gl(b[i][e >> 1], e & 1);
                    acc[st >> 3][st & 1][(st >> 1) & 3][e >> 2][e & 3] *= (1.f + __expf(-gb_)) * __builtin_amdgcn_rcpf(1.f + __expf(-ga_)); } }
            EPI_FENCE();
        }
    }
    __device__ __forceinline__ void operator()(const f32x4 (&acc)[2][2][4][2], const pg8::Unit& u, int wr, int wc, int fr, int fq) const {
        const size_t cbase = (size_t)(u.pn * 256 + wc * 32 + fq * 8);
        u32x4 b0[2], b1[2];
#define MG_LDB(B, gi) do { const size_t o_ = EPI_ROW(gi) * 2048 + cbase; B[0] = *(const u32x4*)(GB + o_); B[1] = *(const u32x4*)(GB + o_ + 128); } while (0)
#define MG_FIN(B, gi) do { _Pragma("unroll") for (int bj = 0; bj < 2; ++bj) { f32x4 o0, o1; \
            _Pragma("unroll") for (int e = 0; e < 4; ++e) { o0[e] = acc[(gi) >> 2][bj][(gi) & 3][0][e] * __builtin_amdgcn_rcpf(1.f + __expf(-gl(B[bj][e >> 1], e & 1))); \
                                                            o1[e] = acc[(gi) >> 2][bj][(gi) & 3][1][e] * __builtin_amdgcn_rcpf(1.f + __expf(-gl(B[bj][2 + (e >> 1)], e & 1))); } \
            *(u32x4*)(MG + EPI_ROW(gi) * 2048 + cbase + bj * 128) = pack8(o0, o1); } } while (0)
        MG_LDB(b0, 0);
#pragma unroll
        for (int gi = 0; gi < 8; gi += 2) {
            MG_LDB(b1, gi + 1); MG_FIN(b0, gi); EPI_FENCE();
            if (gi + 2 < 8) MG_LDB(b0, gi + 2);
            MG_FIN(b1, gi + 1); EPI_FENCE();
        }
#undef MG_LDB
#undef MG_FIN
    }
};
struct EpiOut {
    static constexpr bool PERM = true, HAS_MID = false, HAS_PREFETCH = false;
    const float* x; float* out; bf16* HB; float* sumsq;
    __device__ __forceinline__ void prefetch(const pg8::Unit& u, int wr, int wc, int fr, int fq, LAS unsigned char* junk) const {
        const size_t cbase = (size_t)(u.pn * 256 + wc * 32 + fq * 8);
#pragma unroll
        for (int gi = 0; gi < 8; ++gi) { const float* p_ = x + EPI_ROW(gi) * 2048 + cbase; EPI_PF(p_); EPI_PF(p_ + 4); EPI_PF(p_ + 128); EPI_PF(p_ + 132); }
    }
    __device__ __forceinline__ void operator()(const f32x4 (&acc)[2][2][4][2], const pg8::Unit& u, int wr, int wc, int fr, int fq) const {
        const size_t cbase = (size_t)(u.pn * 256 + wc * 32 + fq * 8);
        f32x4 x0[4], x1[4];
#define EO_LD(X, gi) do { const float* p_ = x + EPI_ROW(gi) * 2048 + cbase; X[0] = *(const f32x4*)p_; X[1] = *(const f32x4*)(p_ + 4); X[2] = *(const f32x4*)(p_ + 128); X[3] = *(const f32x4*)(p_ + 132); } while (0)
#define EO_DO(X, gi) do { const size_t off_ = EPI_ROW(gi) * 2048 + cbase; float ss = 0.f; \
        _Pragma("unroll") for (int bj = 0; bj < 2; ++bj) { const f32x4 h0 = X[2 * bj] + acc[(gi) >> 2][bj][(gi) & 3][0], h1 = X[2 * bj + 1] + acc[(gi) >> 2][bj][(gi) & 3][1]; \
            ss += ((h0[0] * h0[0] + h0[1] * h0[1]) + (h0[2] * h0[2] + h0[3] * h0[3])) + ((h1[0] * h1[0] + h1[1] * h1[1]) + (h1[2] * h1[2] + h1[3] * h1[3])); \
            *(u32x4*)(HB + off_ + bj * 128) = pack8(h0, h1); } \
        ss += __shfl_xor(ss, 16); ss += __shfl_xor(ss, 32); if (fq == 0) atomicAdd(sumsq + EPI_ROW(gi), ss); } while (0)
        EO_LD(x0, 0);
#pragma unroll
        for (int gi = 0; gi < 8; gi += 2) {
            EO_LD(x1, gi + 1); EO_DO(x0, gi); EPI_FENCE();
            if (gi + 2 < 8) EO_LD(x0, gi + 2);
            EO_DO(x1, gi + 1); EPI_FENCE();
        }
#undef EO_LD
#undef EO_DO
    }
};
struct EpiFfn {
    static constexpr bool PERM = true, HAS_MID = false, HAS_PREFETCH = false;
    const float* sumsq; bf16* ACT;
    __device__ __forceinline__ void operator()(const f32x4 (&acc)[2][2][4][2], const pg8::Unit& u, int wr, int wc, int fr, int fq) const {
        float sq[8];
#pragma unroll
        for (int gi = 0; gi < 8; ++gi) sq[gi] = sumsq[EPI_ROW(gi)];
#pragma unroll
        for (int gi = 0; gi < 8; ++gi) { const int ai = gi >> 2, m = gi & 3;
            const float r = 1.0f / sqrtf(sq[gi] * (1.0f / DM) + EPS);
            f32x4 o[2];
#pragma unroll
            for (int n = 0; n < 2; ++n)
#pragma unroll
                for (int e = 0; e < 4; ++e) { const float gg = acc[ai][0][m][n][e] * r, uu = acc[ai][1][m][n][e] * r; o[n][e] = gg * __builtin_amdgcn_rcpf(1.f + __expf(-gg)) * uu; }
            *(u32x4*)(ACT + EPI_ROW(gi) * DFF + u.pn * 128 + wc * 32 + fq * 8) = pack8(o[0], o[1]); }
    }
};
struct EpiDown {
    static constexpr bool PERM = true, HAS_MID = false, HAS_PREFETCH = false;
    float* out; const bf16* HB;
    __device__ __forceinline__ void prefetch(const pg8::Unit& u, int wr, int wc, int fr, int fq, LAS unsigned char* junk) const {}
    __device__ __forceinline__ void operator()(const f32x4 (&acc)[2][2][4][2], const pg8::Unit& u, int wr, int wc, int fr, int fq) const {
        const size_t cbase = (size_t)(u.pn * 256 + wc * 32 + fq * 8);
        u32x4 x0[2], x1[2];
#define ED_LD(X, gi) do { const bf16* p_ = HB + EPI_ROW(gi) * 2048 + cbase; X[0] = *(const u32x4*)p_; X[1] = *(const u32x4*)(p_ + 128); } while (0)
#define ED_LO(w) __uint_as_float((w) << 16)
#define ED_HI(w) __uint_as_float((w) & 0xffff0000u)
#define ED_DO(X, gi) do { float* p_ = out + EPI_ROW(gi) * 2048 + cbase; \
        _Pragma("unroll") for (int bj = 0; bj < 2; ++bj) { \
            const f32x4 r0 = {ED_LO(X[bj].x), ED_HI(X[bj].x), ED_LO(X[bj].y), ED_HI(X[bj].y)}, r1 = {ED_LO(X[bj].z), ED_HI(X[bj].z), ED_LO(X[bj].w), ED_HI(X[bj].w)}; \
            __builtin_nontemporal_store(r0 + acc[(gi) >> 2][bj][(gi) & 3][0], (f32x4*)(p_ + bj * 128)); \
            __builtin_nontemporal_store(r1 + acc[(gi) >> 2][bj][(gi) & 3][1], (f32x4*)(p_ + bj * 128 + 4)); } } while (0)
        ED_LD(x0, 0);
#pragma unroll
        for (int gi = 0; gi < 8; gi += 2) {
            ED_LD(x1, gi + 1); ED_DO(x0, gi); EPI_FENCE();
            if (gi + 2 < 8) ED_LD(x0, gi + 2);
            ED_DO(x1, gi + 1); EPI_FENCE();
        }
#undef ED_LD
#undef ED_DO
#undef ED_LO
#undef ED_HI
    }
};

__device__ __forceinline__ int win_src(int n) {
    if (n < 3072) return n;
    if (n < 4608) return n + 8;
    if (n < 4992) return 4616 + (n - 4608);
    if (n < 5376) return 5256 + (n - 4992);
    if (n < 5760) return 5896 + (n - 5376);
    if (n < 6016) return 5000 + (n - 5760);
    if (n < 6272) return 5640 + (n - 6016);
    if (n < 6528) return 6280 + (n - 6272);
    if (n < 6536) return 3072 + (n - 6528);
    if (n < 6560) return n;
    if (n < 6656) return -1;
    if (n < 8704) return 6560 + (n - 6656);
    return 8608 + (n - 8704);
    return -1;
}
struct TrDesc { const float* src; const float* gain; bf16* dst; int nsrc; int ldT; int valid; };
template <int MAP> __device__ __forceinline__ TrDesc tr_desc(const float* W, const float* W2, int Nsrc, bf16* WT, int ldT, int kdst, const float* gain, int nbn, int item, int lane) {
    const int kb = item / nbn, nb = item - kb * nbn, k0 = 64 * kb, n0 = 32 * nb;
    const int nd = n0 + (lane & 31);
    const float* src = W; int col = nd;
    if (MAP == 1) col = win_src(nd);
    if (MAP == 2) { const int tile = nd >> 8, w = nd & 255; if (w < 128) col = tile * 128 + w; else { col = tile * 128 + w - 128; src = W2; } }
    TrDesc d; d.valid = col >= 0; d.src = src + (size_t)(k0 + (lane >> 5)) * Nsrc + (col >= 0 ? col : 0); d.gain = gain ? gain + k0 + (lane >> 5) : nullptr;
    d.dst = WT + (size_t)n0 * ldT + kdst + k0; d.nsrc = Nsrc; d.ldT = ldT; return d;
}
template <bool NT = false> __device__ __forceinline__ void tr_load(const TrDesc& d, float (&v)[32]) {
#pragma unroll
    for (int i = 0; i < 32; ++i) v[i] = d.valid ? (NT ? __builtin_nontemporal_load(d.src + (size_t)(2 * i) * d.nsrc) : d.src[(size_t)(2 * i) * d.nsrc]) : 0.f;
}
template <bool NT = false> __device__ __forceinline__ void tr_write(const TrDesc& d, const float (&v)[32], LAS float* scr, int lane) {
#pragma unroll
    for (int i = 0; i < 32; ++i) { const int kk = 2 * i + (lane >> 5); scr[kk * 33 + (lane & 31)] = d.gain ? v[i] * d.gain[2 * i] : v[i]; }
    LDS_WAIT();
    const int c = lane & 7;
#pragma unroll
    for (int j = 0; j < 4; ++j) { const int n = (lane >> 3) + 8 * j; const LAS float* s = scr + (8 * c) * 33 + n;
        u32x4 o; o.x = pk2(s[0 * 33], s[1 * 33]); o.y = pk2(s[2 * 33], s[3 * 33]); o.z = pk2(s[4 * 33], s[5 * 33]); o.w = pk2(s[6 * 33], s[7 * 33]);
        if (NT) __builtin_nontemporal_store(o, (u32x4*)(d.dst + (size_t)n * d.ldT + 8 * c)); else *(u32x4*)(d.dst + (size_t)n * d.ldT + 8 * c) = o; }
    LDS_WAIT();
}
template <bool NTW, class F> __device__ __forceinline__ void tr_pipeline3(F desc, int it0, int last, int stride, LAS float* scr, int lane) {
    float v0[32], v1[32], v2[32]; TrDesc d0, d1, d2;
    int a = it0;
    if (a < last) { d0 = desc(a); tr_load<true>(d0, v0); }
    if (a + stride < last) { d1 = desc(a + stride); tr_load<true>(d1, v1); }
    for (;;) {
        if (a >= last) break;
        if (a + 2 * stride < last) { d2 = desc(a + 2 * stride); tr_load<true>(d2, v2); }
        tr_write<NTW>(d0, v0, scr, lane);
        if (a + stride >= last) break;
        if (a + 3 * stride < last) { d0 = desc(a + 3 * stride); tr_load<true>(d0, v0); }
        tr_write<NTW>(d1, v1, scr, lane);
        if (a + 2 * stride >= last) break;
        if (a + 4 * stride < last) { d1 = desc(a + 4 * stride); tr_load<true>(d1, v1); }
        tr_write<NTW>(d2, v2, scr, lane);
        a += 3 * stride;
    }
}
__device__ __forceinline__ void xn_row(const float* xrow, const float* gain, bf16* orow, int lane) {
    const f32x4* xr = (const f32x4*)xrow + lane; const f32x4* gr = (const f32x4*)gain + lane;
    f32x4 v[8]; float s = 0.f;
#pragma unroll
    for (int j = 0; j < 8; ++j) { v[j] = xr[64 * j]; s += (v[j][0] * v[j][0] + v[j][1] * v[j][1]) + (v[j][2] * v[j][2] + v[j][3] * v[j][3]); }
    const float r = 1.0f / sqrtf(wsum(s) * (1.0f / DM) + EPS);
    unsigned long long* o8 = (unsigned long long*)orow + lane;
#pragma unroll
    for (int j = 0; j < 8; ++j) { const f32x4 g = gr[64 * j]; const f32x4 o = v[j] * r * g;
        o8[64 * j] = (unsigned long long)pk2(o[0], o[1]) | ((unsigned long long)pk2(o[2], o[3]) << 32); }
}

__device__ __forceinline__ void xn_row2(const float* xrow, const float* gain, bf16* orow, size_t stride, bool two, int lane) {
    const f32x4* xr = (const f32x4*)xrow + lane; const f32x4* gr = (const f32x4*)gain + lane;
    f32x4 v[8], v2[8]; float s = 0.f, s2 = 0.f;
#pragma unroll
    for (int j = 0; j < 8; ++j) { v[j] = __builtin_nontemporal_load(xr + 64 * j); v2[j] = two ? __builtin_nontemporal_load((const f32x4*)(xrow + stride) + lane + 64 * j) : (f32x4){0.f, 0.f, 0.f, 0.f}; }
#pragma unroll
    for (int j = 0; j < 8; ++j) { s += (v[j][0] * v[j][0] + v[j][1] * v[j][1]) + (v[j][2] * v[j][2] + v[j][3] * v[j][3]); s2 += (v2[j][0] * v2[j][0] + v2[j][1] * v2[j][1]) + (v2[j][2] * v2[j][2] + v2[j][3] * v2[j][3]); }
    const float r = 1.0f / sqrtf(wsum(s) * (1.0f / DM) + EPS), r2 = 1.0f / sqrtf(wsum(s2) * (1.0f / DM) + EPS);
    unsigned long long* o8 = (unsigned long long*)orow + lane; unsigned long long* o82 = (unsigned long long*)(orow + stride) + lane;
#pragma unroll
    for (int j = 0; j < 8; ++j) { const f32x4 g = gr[64 * j]; const f32x4 o = v[j] * r * g, o2 = v2[j] * r2 * g;
        o8[64 * j] = (unsigned long long)pk2(o[0], o[1]) | ((unsigned long long)pk2(o[2], o[3]) << 32);
        if (two) o82[64 * j] = (unsigned long long)pk2(o2[0], o2[1]) | ((unsigned long long)pk2(o2[2], o2[3]) << 32); }
}

constexpr int LDS_BYTES = 147456;
constexpr int NWAVES = 8, NTHREADS = 512;

enum { PH_P0 = 0, PH_GEMM1, PH_P2A, PH_P2B, PH_ATTN, PH_MERGE, PH_OUT, PH_FFN, PH_DOWN, PH_N };

__device__ __forceinline__ void phase_mix_weights(const Params& p, LAS unsigned char* lds, int cw, int NCW, int wave, int lane) {
    unsigned char* ws = p.ws;
    LAS float* scr = (LAS float*)(lds + wave * 16384);
    constexpr int I_WU = 16 * 64, I_WOUT = 32 * 64, NIT = 2 * I_WU + I_WOUT;
    auto desc = [&](int it) -> TrDesc {
        int r = it;
        if (r < I_WU) return tr_desc<0>(p.in[I_W_UP_FOX], nullptr, 2048, (bf16*)(ws + WS_WU), 2048, 0, nullptr, 64, r, lane);
        r -= I_WU;
        if (r < I_WU) return tr_desc<0>(p.in[I_W_UP_NSA], nullptr, 2048, (bf16*)(ws + WS_WU), 2048, 1024, nullptr, 64, r, lane);
        r -= I_WU;
        return tr_desc<0>(p.in[I_W_OUT], nullptr, 2048, (bf16*)(ws + WS_WOUT), 2048, 0, nullptr, 64, r, lane);
    };
    tr_pipeline3<false>(desc, cw, NIT, NCW, scr, lane);
}

__device__ __forceinline__ void phase_p0(const Params& p, LAS unsigned char* lds, int gw, int NGW, int wave, int lane) {
    unsigned char* ws = p.ws;
    LAS float* scr = (LAS float*)(lds + wave * 16384);
    constexpr int I_WIN = 32 * (DINP / 32), I_C1K = 96 * 8, I_C1V = 64 * 8;
    constexpr int NIT = I_WIN + I_C1K + I_C1V;
    auto desc = [&](int it) -> TrDesc {
        int r = it;
        if (r < I_WIN) return tr_desc<1>(p.in[I_W_IN], nullptr, DIN, (bf16*)(ws + WS_WIN), 2048, 0, nullptr, DINP / 32, r, lane);
        r -= I_WIN;
        if (r < I_C1K) return tr_desc<0>(p.in[I_W1_K], nullptr, 256, (bf16*)(ws + WS_CW1K), 6144, 0, nullptr, 8, r, lane);
        r -= I_C1K;
        return tr_desc<0>(p.in[I_W1_V], nullptr, 256, (bf16*)(ws + WS_CW1V), 4096, 0, nullptr, 8, r, lane);
    };
    {
        float va[32], vb[32]; TrDesc d, dn;
        int it = gw;
        if (it < NIT) { d = desc(it); tr_load<true>(d, va); }
        while (it < NIT) {
            const int itn = it + NGW;
            if (itn < NIT) { dn = desc(itn); tr_load<true>(dn, vb); }
            tr_write(d, va, scr, lane);
            it = itn; d = dn;
#pragma unroll
            for (int i = 0; i < 32; ++i) va[i] = vb[i];
        }
    }
    for (int m = gw; m < MTOK; m += 2 * NGW) xn_row2(p.in[I_X] + (size_t)m * DM, p.in[I_NORM_ATTN], (bf16*)(ws + WS_XN) + (size_t)m * DM, (size_t)NGW * DM, m + NGW < MTOK, lane);
    for (int s = gw; s < 96 + 64; s += NGW) {
        const bool isv = s >= 96; const int sl = isv ? s - 96 : s;
        const float* pe = p.in[isv ? I_PE_V : I_PE_K] + sl * 64; const float* w = p.in[isv ? I_W1_V : I_W1_K] + (size_t)sl * 64 * 256 + 4 * lane;
        f32x4 a = {0.f, 0.f, 0.f, 0.f};
        for (int k0 = 0; k0 < 64; k0 += 16) { f32x4 t[16]; float pv[16];
#pragma unroll
            for (int e = 0; e < 16; ++e) { t[e] = *(const f32x4*)(w + (size_t)(k0 + e) * 256); pv[e] = pe[k0 + e]; }
#pragma unroll
            for (int e = 0; e < 16; ++e) a += t[e] * pv[e]; }
        *(f32x4*)((float*)(ws + (isv ? WS_BPV : WS_BPK)) + sl * 256 + 4 * lane) = a;
    }
    for (int i = gw * 64 + lane; i < MTOK; i += NGW * 64) ((float*)(ws + WS_SUMSQ))[i] = 0.f;
    for (int i = gw * 64 + lane; i < 12 * MTOK; i += NGW * 64) ((float*)(ws + WS_SSQ))[i] = 0.f;
}

__device__ __forceinline__ float log_sigmoid(float z) { return fminf(z, 0.f) - log1pf(__expf(-fabsf(z))); }

__device__ __forceinline__ float log_sigmoid_fast(float z) { return fminf(z, 0.f) - __logf(1.f + __expf(-fabsf(z))); }
__device__ __forceinline__ void phase_cumsum(const Params& p, int gw, int NGW, int lane) {
    unsigned char* ws = p.ws;
    asm volatile("" : "+v"(lane));
    for (int task = gw; task < BATCH * FH; task += NGW) {
        const int b = task / FH, h = task - b * FH; const float bias = p.in[I_FOX_F_BIAS][h];
        const float* sm = (const float*)(ws + WS_SMALL) + ((size_t)b * SEQ + 32 * lane) * 32 + h;
        float v[32];
#pragma unroll
        for (int i = 0; i < 32; ++i) v[i] = sm[(size_t)i * 32];
        float run = 0.f;
#pragma unroll
        for (int i = 0; i < 32; ++i) { run += log_sigmoid_fast(v[i] + bias); v[i] = run; }
        float incl = run;
#pragma unroll
        for (int o = 1; o < 64; o <<= 1) { const float y = __shfl_up(incl, o); if (lane >= o) incl += y; }
        const float off = incl - run;
        f32x4* cf = (f32x4*)((float*)(ws + WS_CF) + ((size_t)b * FH + h) * SEQ + 32 * lane);
#pragma unroll
        for (int i = 0; i < 8; ++i) cf[i] = (f32x4){v[4 * i] + off, v[4 * i + 1] + off, v[4 * i + 2] + off, v[4 * i + 3] + off};
    }
}
__device__ __forceinline__ void phase_ffn_weights(const Params& p, LAS unsigned char* lds, int cw, int NCW, int wave, int lane, int first, int last  ) {
    unsigned char* ws = p.ws;
    LAS float* scr = (LAS float*)(lds + wave * 16384);
    constexpr int I_GU = 32 * (NGU / 32), I_D = (DFF / 64) * 64;
    auto desc = [&](int it) -> TrDesc {
        if (it < I_GU) return tr_desc<2>(p.in[I_W_GATE], p.in[I_W_UP], DFF, (bf16*)(ws + WS_WGU), 2048, 0, p.in[I_NORM_FFN], NGU / 32, it, lane);
        return tr_desc<0>(p.in[I_W_DOWN], nullptr, 2048, (bf16*)(ws + WS_WD), DFF, 0, nullptr, 64, it - I_GU, lane);
    };
    tr_pipeline3<true>(desc, first + cw, last, NCW, scr, lane);
}

constexpr int CONV_GU_SPLIT = 8192;

__device__ __forceinline__ void cmp_finish_unit(const Params& p, LAS unsigned char* lds, int u, int tid) {
    unsigned char* ws = p.ws;
    asm volatile("" : "+v"(tid));
    const bool isv = u >= 128; const int r0 = (u & 127) * 8;
    const int nsl = isv ? KS_V : KS_K, nbp = isv ? 64 : 96, ncol = isv ? 128 : 192;
    const float* slab = (const float*)(ws + (isv ? WS_HSLV : WS_HSLK)); const float* bp = (const float*)(ws + (isv ? WS_BPV : WS_BPK));
    const float* w2 = p.in[isv ? I_W2_V : I_W2_K];
    LAS float* hid = (LAS float*)lds;
    LAS float* bias = hid + 8 * 256;
    LAS float* ob = bias + 256;
    if (tid < 256) bias[tid] = ((const float*)(ws + WS_BIAS))[(isv ? 256 : 0) + tid];
    __syncthreads();
    for (int idx = tid; idx < 8 * 256; idx += NTHREADS) { const int r = idx >> 8, n = idx & 255; float s = bias[n]; float t[12];
#pragma unroll
        for (int k = 0; k < 12; ++k) t[k] = k < nsl ? slab[((size_t)k * CROWS + r0 + r) * 256 + n] : 0.f;
#pragma unroll
        for (int k = 0; k < 12; ++k) s += t[k];
        hid[idx] = s / (1.f + __expf(-s)); }
    __syncthreads();
    const int c = tid & 255, rg = tid >> 8;
    float a[4] = {0.f, 0.f, 0.f, 0.f};
    if (c < ncol) {
        float w[16], wn[16];
#pragma unroll
        for (int i = 0; i < 16; ++i) w[i] = w2[(size_t)i * ncol + c];
        for (int n0 = 0; n0 < 256; n0 += 16) {
            if (n0 + 16 < 256) {
#pragma unroll
                for (int i = 0; i < 16; ++i) wn[i] = w2[(size_t)(n0 + 16 + i) * ncol + c];
            }
#pragma unroll
            for (int i4 = 0; i4 < 4; ++i4)
#pragma unroll
                for (int r = 0; r < 4; ++r) { const f32x4 h = *(const LAS f32x4*)(hid + (rg * 4 + r) * 256 + n0 + 4 * i4);
                    a[r] += (h[0] * w[4 * i4] + h[1] * w[4 * i4 + 1]) + (h[2] * w[4 * i4 + 2] + h[3] * w[4 * i4 + 3]); }
#pragma unroll
            for (int i = 0; i < 16; ++i) w[i] = wn[i];
        }
        if (isv) {
#pragma unroll
            for (int r = 0; r < 4; ++r) ((bf16*)(ws + WS_VCC))[(size_t)(r0 + rg * 4 + r) * 128 + c] = (bf16)f2bf(a[r]);
        } else {
#pragma unroll
            for (int r = 0; r < 4; ++r) ob[(rg * 4 + r) * 192 + c] = a[r];
        }
    }
    __syncthreads();
    if (!isv) {
        const int w = tid >> 6, lane = tid & 63;
        const float v0 = ob[w * 192 + lane], v1 = ob[w * 192 + 64 + lane], v2 = ob[w * 192 + 128 + lane];
        const float r = 1.0f / sqrtf(wsum(v0 * v0 + v1 * v1 + v2 * v2) * (1.0f / 192.f) + EPS);
        const float* g = p.in[I_NSA_KC_GAIN]; bf16* o = (bf16*)(ws + WS_KCC) + (size_t)(r0 + w) * 192;
        o[lane] = (bf16)f2bf(v0 * r * g[lane]); o[64 + lane] = (bf16)f2bf(v1 * r * g[64 + lane]); o[128 + lane] = (bf16)f2bf(v2 * r * g[128 + lane]);
    }
    __syncthreads();
}


namespace att {
typedef short v4i16 __attribute__((ext_vector_type(4)));
typedef float f32x2_t __attribute__((ext_vector_type(2)));
typedef __bf16 bf16x2_t __attribute__((ext_vector_type(2)));
constexpr float LOG2E = 1.4426950408889634f;
constexpr int VP = 288;
constexpr int LDS_K0 = 0, LDS_K1 = 26624, LDS_V0 = 53248, LDS_V1 = 71680, LDS_IMP = 90112  , LDS_TOT = 122880  , LDS_SEL = 131072  ,
              LDS_AUX = 131584  , LDS_QW = 132608  , LDS_GATE = 133120  ;
__device__ __forceinline__ unsigned cvtpk(float lo, float hi) { f32x2_t v = {lo, hi}; bf16x2_t b = __builtin_convertvector(v, bf16x2_t); return __builtin_bit_cast(unsigned, b); }
__device__ __forceinline__ float x16(float v, float& o) { const auto r = __builtin_amdgcn_permlane16_swap(__float_as_uint(v), __float_as_uint(v), false, false); o = __uint_as_float(r[1]); return __uint_as_float(r[0]); }
__device__ __forceinline__ float x32(float v, float& o) { const auto r = __builtin_amdgcn_permlane32_swap(__float_as_uint(v), __float_as_uint(v), false, false); o = __uint_as_float(r[1]); return __uint_as_float(r[0]); }
__device__ __forceinline__ float gmax(float v) { float o; float a = x16(v, o); v = fmaxf(a, o); a = x32(v, o); return fmaxf(a, o); }
__device__ __forceinline__ float gsum(float v) { float o; float a = x16(v, o); v = a + o; a = x32(v, o); return a + o; }
template <int DKT> __device__ __forceinline__ int koff(int row, int ch) { return row * (DKT * 2 + 32) + (ch << 4); }
__device__ __forceinline__ int voff(int row, int ch) { return row * VP + (ch << 4); }

template <int DKT, int MODE> struct Stage {
    static constexpr int KCH = DKT / 8, NKP = DKT / 64;
    u32x4 k[NKP]; u32x4 v[2]; f32x4 aux;
    __device__ __forceinline__ void load(const bf16* Kg, int kpitch, const bf16* Vg, int vpitch, const float* cf, const float* rk, int j, int tid) {
        const int row = tid >> 3, c8 = tid & 7;
        const char* kt = (const char*)(Kg + (size_t)(64 * j) * kpitch); const unsigned ko = (unsigned)(row * kpitch + c8 * 8) * 2u;
        const char* vt = (const char*)(Vg + (size_t)(64 * j) * vpitch); const unsigned vo = (unsigned)(row * vpitch + c8 * 8) * 2u;
#pragma unroll
        for (int i = 0; i < NKP; ++i) k[i] = *(const u32x4*)(kt + ko + 128 * i);
#pragma unroll
        for (int i = 0; i < 2; ++i) v[i] = *(const u32x4*)(vt + vo + 128 * i);
        if (MODE != 1) { if (tid < 32) { const float* src = (MODE == 0 && tid < 16) ? cf : rk; aux = *(const f32x4*)(src + 64 * j + 4 * (tid & 15)); } }
    }
    __device__ __forceinline__ void store(LAS unsigned char* Kb, LAS unsigned char* Vb, LAS float* auxb, float cref, int tid) const {
        const int row = tid >> 3, c8 = tid & 7;
#pragma unroll
        for (int i = 0; i < NKP; ++i) *(LAS u32x4*)(Kb + koff<DKT>(row, c8 + 8 * i)) = k[i];
#pragma unroll
        for (int i = 0; i < 2; ++i) *(LAS u32x4*)(Vb + voff(row, c8 + 8 * i)) = v[i];
        if (MODE != 1) { if (tid < 32) { f32x4 o;
            if (MODE == 0 && tid < 16) o = (cref - aux) * LOG2E;
            else { const f32x4 sq = aux * (1.0f / DKT) + EPS; o = (f32x4){__builtin_amdgcn_rsqf(sq[0]), __builtin_amdgcn_rsqf(sq[1]), __builtin_amdgcn_rsqf(sq[2]), __builtin_amdgcn_rsqf(sq[3])}; }
            *(LAS f32x4*)(auxb + ((MODE == 0 && tid < 16) ? 0 : 64) + 4 * (tid & 15)) = o; } }
    }
};

struct Ctx {
    float sl;
    const float* cf;
    const float* rk;
    float cref;
    int q0;
    int tq0;
    unsigned selm[2];
};

template <int DKT, int MODE> __device__ __forceinline__ void qk_half(f32x4 (&S)[2][2], const LAS unsigned char* Kb, const LAS float* auxb, const bf16x8 (&Q)[2][DKT / 32], const Ctx& c, int j, int hf, bool need_mask, int lane) {
    const int i16 = lane & 15, g = lane >> 4;
    const int kbase = i16 * (DKT * 2 + 32) + g * 16;
#pragma unroll
    for (int k2 = 0; k2 < 2; ++k2) {
        if (MODE == 1) { const int kl0 = 64 * j + 16 * (2 * hf + k2) + 4 * g; const float b0 = c.sl * (float)(16 * kl0 + 31 - c.q0);
            const f32x4 bias = (f32x4){b0, b0 + 16.f * c.sl, b0 + 32.f * c.sl, b0 + 48.f * c.sl}; S[0][k2] = bias; S[1][k2] = bias; }
        else { S[0][k2] = (f32x4){0.f, 0.f, 0.f, 0.f}; S[1][k2] = (f32x4){0.f, 0.f, 0.f, 0.f}; }
    }
    {
        bf16x8 ka[2], kb[2];
#define ATT_LDK(dst, ks_) do { _Pragma("unroll") for (int k2 = 0; k2 < 2; ++k2) dst[k2] = *(const LAS bf16x8*)(Kb + kbase + ((2 * hf + k2) * 16 * (DKT * 2 + 32) + (ks_) * 64)); } while (0)
#define ATT_MMK(src, ks_) do { _Pragma("unroll") for (int k2 = 0; k2 < 2; ++k2) { \
        S[0][k2] = __builtin_amdgcn_mfma_f32_16x16x32_bf16(src[k2], Q[0][ks_], S[0][k2], 0, 0, 0); \
        S[1][k2] = __builtin_amdgcn_mfma_f32_16x16x32_bf16(src[k2], Q[1][ks_], S[1][k2], 0, 0, 0); } } while (0)
        ATT_LDK(ka, 0);
#pragma unroll
        for (int ks = 0; ks < DKT / 32; ks += 2) {
            ATT_LDK(kb, ks + 1);
            ATT_MMK(ka, ks);
            if (ks + 2 < DKT / 32) ATT_LDK(ka, ks + 2);
            ATT_MMK(kb, ks + 1);
        }
#undef ATT_LDK
#undef ATT_MMK
    }
    if (MODE != 1) {
#pragma unroll
        for (int k2 = 0; k2 < 2; ++k2) {
            const int kq = 16 * (2 * hf + k2) + 4 * g;
            const f32x4 rs = *(const LAS f32x4*)(auxb + 64 + kq);
            f32x4 bias;
            if (MODE == 0) bias = *(const LAS f32x4*)(auxb + kq);
            else { const float b0 = c.sl * (float)(64 * j + kq - c.q0); bias = (f32x4){b0, b0 + c.sl, b0 + 2.f * c.sl, b0 + 3.f * c.sl}; }
#pragma unroll
            for (int e = 0; e < 4; ++e) { float t0 = __builtin_fmaf(S[0][k2][e], rs[e], bias[e]), t1 = __builtin_fmaf(S[1][k2][e], rs[e], bias[e]);
                                          asm("" : "+v"(t0)); asm("" : "+v"(t1)); S[0][k2][e] = t0; S[1][k2][e] = t1; }
        }
    }
    if (need_mask) {
#pragma unroll
        for (int qg = 0; qg < 2; ++qg)
#pragma unroll
            for (int k2 = 0; k2 < 2; ++k2)
#pragma unroll
                for (int r = 0; r < 4; ++r) {
                    const int kl = 64 * j + 16 * (2 * hf + k2) + 4 * g + r; bool ok;
                    if (MODE == 0) ok = kl <= (c.tq0 + 16 * qg);
                    else if (MODE == 1) ok = 16 * kl + 31 <= (c.tq0 + 16 * qg);
                    else if (MODE == 2) ok = (kl <= (c.tq0 + 16 * qg)) && ((c.selm[qg] >> j) & 1u);
                    else ok = (kl <= (c.tq0 + 16 * qg)) && ((c.tq0 + 16 * qg) - kl < 512);
                    if (!ok) S[qg][k2][r] = -INFINITY;
                }
    }
}

__device__ __forceinline__ void softmax_pv_half(f32x4 (&S)[2][2], const LAS unsigned char* Vb, int hf, f32x4 (&O)[2][8], float (&m)[2], float (&l)[2], int lane) {
    const int i16 = lane & 15, g = lane >> 4;
    bf16x8 P[2];
#pragma unroll
    for (int qg = 0; qg < 2; ++qg) {
        float tm = fmaxf(fmaxf(fmaxf(S[qg][0][0], S[qg][0][1]), fmaxf(S[qg][0][2], S[qg][0][3])), fmaxf(fmaxf(S[qg][1][0], S[qg][1][1]), fmaxf(S[qg][1][2], S[qg][1][3])));
        tm = gmax(tm);
        const float mn = fmaxf(m[qg], tm), mr = (mn == -INFINITY) ? 0.f : mn;
        const float alpha = __builtin_amdgcn_exp2f(m[qg] - mr); m[qg] = mn;
        float ls = 0.f;
#pragma unroll
        for (int k2 = 0; k2 < 2; ++k2)
#pragma unroll
            for (int r = 0; r < 4; ++r) { const float pv = __builtin_amdgcn_exp2f(S[qg][k2][r] - mr); S[qg][k2][r] = pv; ls += pv; }
        l[qg] = l[qg] * alpha + ls;
        if (__any(alpha < 1.f)) {
#pragma unroll
            for (int db = 0; db < 8; ++db) O[qg][db] *= alpha;
        }
        u32x4 w; w.x = cvtpk(S[qg][0][0], S[qg][0][1]); w.y = cvtpk(S[qg][0][2], S[qg][0][3]); w.z = cvtpk(S[qg][1][0], S[qg][1][1]); w.w = cvtpk(S[qg][1][2], S[qg][1][3]);
        P[qg] = __builtin_bit_cast(bf16x8, w);
    }
    const int q4 = i16 >> 2, p4 = i16 & 3;
    const int vbase = (4 * g + q4) * VP + (p4 >> 1) * 16 + (p4 & 1) * 8;
    {
        v4i16 a0[2], b0[2], a1[2], b1[2];
#define ATT_LDV(A, B, gi) do { _Pragma("unroll") for (int e = 0; e < 2; ++e) { const int db = 2 * (gi) + e; \
        A[e] = __builtin_amdgcn_ds_read_tr16_b64_v4i16((LAS v4i16*)(Vb + vbase + (hf * 32 * VP + db * 32))); \
        B[e] = __builtin_amdgcn_ds_read_tr16_b64_v4i16((LAS v4i16*)(Vb + vbase + (hf * 32 * VP + 16 * VP + db * 32))); } } while (0)
#define ATT_MMV(A, B, gi) do { _Pragma("unroll") for (int e = 0; e < 2; ++e) { const int db = 2 * (gi) + e; \
        const bf16x8 vf = (bf16x8){A[e][0], A[e][1], A[e][2], A[e][3], B[e][0], B[e][1], B[e][2], B[e][3]}; \
        O[0][db] = __builtin_amdgcn_mfma_f32_16x16x32_bf16(vf, P[0], O[0][db], 0, 0, 0); \
        O[1][db] = __builtin_amdgcn_mfma_f32_16x16x32_bf16(vf, P[1], O[1][db], 0, 0, 0); } } while (0)
        ATT_LDV(a0, b0, 0);
        ATT_LDV(a1, b1, 1); ATT_MMV(a0, b0, 0);
        ATT_LDV(a0, b0, 2); ATT_MMV(a1, b1, 1);
        ATT_LDV(a1, b1, 3); ATT_MMV(a0, b0, 2);
        ATT_MMV(a1, b1, 3);
#undef ATT_LDV
#undef ATT_MMV
    }
}

__device__ __forceinline__ void softmax_pv_full(f32x4 (&S)[2][2], f32x4 (&S1)[2][2], const LAS unsigned char* Vb, f32x4 (&O)[2][8], float (&m)[2], float (&l)[2], int lane) {
    const int i16 = lane & 15, g = lane >> 4;
    bf16x8 P[2][2];
#pragma unroll
    for (int qg = 0; qg < 2; ++qg) {
        float tm = fmaxf(fmaxf(fmaxf(S[qg][0][0], S[qg][0][1]), fmaxf(S[qg][0][2], S[qg][0][3])), fmaxf(fmaxf(S[qg][1][0], S[qg][1][1]), fmaxf(S[qg][1][2], S[qg][1][3])));
        const float tm1 = fmaxf(fmaxf(fmaxf(S1[qg][0][0], S1[qg][0][1]), fmaxf(S1[qg][0][2], S1[qg][0][3])), fmaxf(fmaxf(S1[qg][1][0], S1[qg][1][1]), fmaxf(S1[qg][1][2], S1[qg][1][3])));
        tm = gmax(fmaxf(tm, tm1));
        const float mn = fmaxf(m[qg], tm), mr = (mn == -INFINITY) ? 0.f : mn;
        const float alpha = __builtin_amdgcn_exp2f(m[qg] - mr); m[qg] = mn;
        float ls = 0.f, ls1 = 0.f;
#pragma unroll
        for (int k2 = 0; k2 < 2; ++k2)
#pragma unroll
            for (int r = 0; r < 4; ++r) { const float pv = __builtin_amdgcn_exp2f(S[qg][k2][r] - mr); S[qg][k2][r] = pv; ls += pv;
                                          const float pw = __builtin_amdgcn_exp2f(S1[qg][k2][r] - mr); S1[qg][k2][r] = pw; ls1 += pw; }
        l[qg] = l[qg] * alpha + (ls + ls1);
        if (__any(alpha < 1.f)) {
#pragma unroll
            for (int db = 0; db < 8; ++db) O[qg][db] *= alpha;
        }
        u32x4 w; w.x = cvtpk(S[qg][0][0], S[qg][0][1]); w.y = cvtpk(S[qg][0][2], S[qg][0][3]); w.z = cvtpk(S[qg][1][0], S[qg][1][1]); w.w = cvtpk(S[qg][1][2], S[qg][1][3]);
        P[0][qg] = __builtin_bit_cast(bf16x8, w);
        w.x = cvtpk(S1[qg][0][0], S1[qg][0][1]); w.y = cvtpk(S1[qg][0][2], S1[qg][0][3]); w.z = cvtpk(S1[qg][1][0], S1[qg][1][1]); w.w = cvtpk(S1[qg][1][2], S1[qg][1][3]);
        P[1][qg] = __builtin_bit_cast(bf16x8, w);
    }
    const int q4 = i16 >> 2, p4 = i16 & 3;
    const int vbase = (4 * g + q4) * VP + (p4 >> 1) * 16 + (p4 & 1) * 8;
    {
        v4i16 a0[2], b0[2], a1[2], b1[2];
#define ATT_LDV(A, B, gi) do { _Pragma("unroll") for (int e = 0; e < 2; ++e) { const int db = 2 * ((gi) & 3) + e, hf = (gi) >> 2; \
        A[e] = __builtin_amdgcn_ds_read_tr16_b64_v4i16((LAS v4i16*)(Vb + vbase + (hf * 32 * VP + db * 32))); \
        B[e] = __builtin_amdgcn_ds_read_tr16_b64_v4i16((LAS v4i16*)(Vb + vbase + (hf * 32 * VP + 16 * VP + db * 32))); } } while (0)
#define ATT_MMV(A, B, gi) do { _Pragma("unroll") for (int e = 0; e < 2; ++e) { const int db = 2 * ((gi) & 3) + e, hf = (gi) >> 2; \
        const bf16x8 vf = (bf16x8){A[e][0], A[e][1], A[e][2], A[e][3], B[e][0], B[e][1], B[e][2], B[e][3]}; \
        O[0][db] = __builtin_amdgcn_mfma_f32_16x16x32_bf16(vf, P[hf][0], O[0][db], 0, 0, 0); \
        O[1][db] = __builtin_amdgcn_mfma_f32_16x16x32_bf16(vf, P[hf][1], O[1][db], 0, 0, 0); } } while (0)
        ATT_LDV(a0, b0, 0);
        ATT_LDV(a1, b1, 1); ATT_MMV(a0, b0, 0);
        ATT_LDV(a0, b0, 2); ATT_MMV(a1, b1, 1);
        ATT_LDV(a1, b1, 3); ATT_MMV(a0, b0, 2);
        ATT_LDV(a0, b0, 4); ATT_MMV(a1, b1, 3);
        ATT_LDV(a1, b1, 5); ATT_MMV(a0, b0, 4);
        ATT_LDV(a0, b0, 6); ATT_MMV(a1, b1, 5);
        ATT_LDV(a1, b1, 7); ATT_MMV(a0, b0, 6);
        ATT_MMV(a1, b1, 7);
#undef ATT_LDV
#undef ATT_MMV
    }
}

template <int DKT, int MODE> __device__ __forceinline__ void branch(LAS unsigned char* lds, unsigned tiles, unsigned mskb, unsigned skipb, const bf16* Kg, int kpitch, const bf16* Vg, int vpitch,
                                                                    const bf16x8 (&Q)[2][DKT / 32], f32x4 (&O)[2][8], float (&m)[2], float (&l)[2], const Ctx& c, int tid, int lane,
                                                                    Stage<DKT, MODE>& st, bool preloaded  ) {
    LAS float* AUX = (LAS float*)(lds + LDS_AUX);
    int j = 31 - __builtin_clz(tiles), ib = 0;
    asm volatile("" : "+v"(tid), "+v"(lane));
    if (!preloaded) st.load(Kg, kpitch, Vg, vpitch, c.cf, c.rk, j, tid);
    st.store(lds + LDS_K0, lds + LDS_V0, AUX, c.cref, tid);
    tiles &= ~(1u << j);
    int nj = tiles ? 31 - __builtin_clz(tiles) : -1;
    if (nj >= 0) st.load(Kg, kpitch, Vg, vpitch, c.cf, c.rk, nj, tid);
    __syncthreads();
    for (;;) {
        asm volatile("" : "+v"(tid), "+v"(lane));
        const LAS unsigned char* Kb = lds + (ib ? LDS_K1 : LDS_K0); const LAS unsigned char* Vb = lds + (ib ? LDS_V1 : LDS_V0); const LAS float* auxb = AUX + (ib ? 128 : 0);
        const bool skip = (skipb >> j) & 1u, nm = (mskb >> j) & 1u;
        f32x4 S[2][2], S1[2][2];
        if (!skip) {
            qk_half<DKT, MODE>(S, Kb, auxb, Q, c, j, 0, nm, lane); qk_half<DKT, MODE>(S1, Kb, auxb, Q, c, j, 1, nm, lane);
        }
        int nn = -1;
        if (nj >= 0) { st.store(lds + (ib ? LDS_K0 : LDS_K1), lds + (ib ? LDS_V0 : LDS_V1), AUX + (ib ? 0 : 128), c.cref, tid);
            tiles &= ~(1u << nj); nn = tiles ? 31 - __builtin_clz(tiles) : -1;
            if (nn >= 0) st.load(Kg, kpitch, Vg, vpitch, c.cf, c.rk, nn, tid); }
        if (!skip) softmax_pv_full(S, S1, Vb, O, m, l, lane);
        __syncthreads();
        if (nj < 0) break;
        ib ^= 1; j = nj; nj = nn;
    }
}

template <int DKT> __device__ __forceinline__ void load_q(bf16x8 (&Q)[2][DKT / 32], const bf16* qrow0  , size_t qg_stride, const float* gain, const float* gain2, float scale, int lane) {
    const int g = lane >> 4;
#pragma unroll
    for (int qg = 0; qg < 2; ++qg) {
        u32x4 raw[DKT / 32]; float ss = 0.f;
#pragma unroll
        for (int ks = 0; ks < DKT / 32; ++ks) { raw[ks] = *(const u32x4*)(qrow0 + qg * qg_stride + 32 * ks + 8 * g);
#pragma unroll
            for (int e = 0; e < 4; ++e) { const float a = __uint_as_float(raw[ks][e] << 16), b = __uint_as_float(raw[ks][e] & 0xffff0000u); ss += a * a + b * b; } }
        ss = gsum(ss);
        const float r = scale / sqrtf(ss * (1.0f / DKT) + EPS);
#pragma unroll
        for (int ks = 0; ks < DKT / 32; ++ks) asm volatile("" : "+v"(raw[ks]));
#pragma unroll
        for (int ks = 0; ks < DKT / 32; ++ks) { f32x4 g0 = *(const f32x4*)(gain + 32 * ks + 8 * g), g1 = *(const f32x4*)(gain + 32 * ks + 8 * g + 4); u32x4 w;
            if (gain2) { g0 *= *(const f32x4*)(gain2 + 32 * ks + 8 * g); g1 *= *(const f32x4*)(gain2 + 32 * ks + 8 * g + 4); }
#pragma unroll
            for (int e = 0; e < 4; ++e) { const float a = __uint_as_float(raw[ks][e] << 16), b = __uint_as_float(raw[ks][e] & 0xffff0000u);
                const float ga = e < 2 ? g0[2 * e] : g1[2 * e - 4], gb = e < 2 ? g0[2 * e + 1] : g1[2 * e - 3]; w[e] = cvtpk(a * r * ga, b * r * gb); }
            Q[qg][ks] = __builtin_bit_cast(bf16x8, w); }
    }
}

__device__ __forceinline__ void fox_unit(const Params& p, LAS unsigned char* lds, int b, int h, int qb, int tid, int wave, int lane, unsigned* qctr, volatile LAS unsigned* qslot) {
    unsigned char* ws = p.ws;
    asm volatile("" : "+v"(tid), "+v"(lane));
    const int i16 = lane & 15, g = lane >> 4, q0 = 256 * qb;
    const size_t rowb = (size_t)b * SEQ;
    bf16x8 Q[2][4];
    load_q<128>(Q, (const bf16*)(ws + WS_FQ) + (rowb + q0 + 32 * wave + i16) * 1024 + h * 128, (size_t)16 * 1024, p.in[I_FOX_Q_GAIN], p.in[I_FOX_K_GAIN], 0.08838834764831845f * LOG2E, lane);
    Ctx c; c.sl = 0.f; c.cf = (const float*)(ws + WS_CF) + ((size_t)b * FH + h) * SEQ; c.cref = c.cf[q0]; c.q0 = q0;
    c.rk = (const float*)(ws + WS_SSQ) + (size_t)h * MTOK + rowb;
    c.tq0 = q0 + 32 * wave + i16; c.selm[0] = 0u; c.selm[1] = 0u;
    f32x4 O[2][8]; float m[2] = {-INFINITY, -INFINITY}, l[2] = {0.f, 0.f};
#pragma unroll
    for (int qg = 0; qg < 2; ++qg)
#pragma unroll
        for (int db = 0; db < 8; ++db) O[qg][db] = (f32x4){0.f, 0.f, 0.f, 0.f};
    const unsigned nt = 4 * qb + 4, tiles = nt >= 32 ? 0xffffffffu : ((1u << nt) - 1u);
    const int qw = q0 + 32 * wave; const int jfull = (qw + 1) >> 6  , jvis = ((qw + 31) >> 6) + 1  ;
    const unsigned mskb = ~(jfull >= 32 ? 0xffffffffu : ((1u << jfull) - 1u)), skipb = jvis >= 32 ? 0u : ~((1u << jvis) - 1u);
    { Stage<128, 0> st0; branch<128, 0>(lds, tiles, mskb, skipb, (const bf16*)(ws + WS_FK) + rowb * 1024 + h * 128, 1024, (const bf16*)(ws + WS_FV) + rowb * 1024 + h * 128, 1024, Q, O, m, l, c, tid, lane, st0, false); }
    unsigned nxt = 0u;
    { int t0 = tid; asm volatile("" : "+v"(t0)); if (t0 == 0) nxt = __hip_atomic_fetch_add(qctr, 1u, __ATOMIC_RELAXED, __HIP_MEMORY_SCOPE_AGENT); }
#pragma unroll
    for (int qg = 0; qg < 2; ++qg) {
        const float lt = gsum(l[qg]);
        const float inv = 1.0f / lt;
        bf16* orow = (bf16*)(ws + WS_OAB) + (rowb + (c.tq0 + 16 * qg)) * 2048 + h * 128 + 4 * g;
#pragma unroll
        for (int db = 0; db < 8; ++db) { const f32x4 o = O[qg][db] * inv; *(u32x2*)(orow + 16 * db) = (u32x2){cvtpk(o[0], o[1]), cvtpk(o[2], o[3])}; }
    }
    { int t0 = tid; asm volatile("" : "+v"(t0)); if (t0 == 0) qslot[0] = nxt; }
}

__device__ __forceinline__ float ulo(unsigned w) { return __uint_as_float(w << 16); }
__device__ __forceinline__ float uhi(unsigned w) { return __uint_as_float(w & 0xffff0000u); }

__device__ __forceinline__ void nsa_unit(const Params& p, LAS unsigned char* lds, int b, int gq, int cur, int tid, int wave, int lane, unsigned* qctr, volatile LAS unsigned* qslot) {
    unsigned char* ws = p.ws;
    asm volatile("" : "+v"(tid), "+v"(lane));
    const int i16 = lane & 15, g = lane >> 4, q0 = 64 * cur, hh = wave >> 1, h = gq * HPG + hh, rbase = 32 * (wave & 1);
    const size_t rowb = (size_t)b * SEQ;
    bf16x8 Q[2][6];
#define ATT_LOADQ(g2) do { int ln_ = lane; asm volatile("" : "+v"(ln_)); \
        load_q<192>(Q, (const bf16*)(ws + WS_NQ) + (rowb + q0 + rbase + (ln_ & 15)) * 1536 + h * 192, (size_t)16 * 1536, p.in[I_NSA_Q_GAIN], (g2), 0.07216878364870322f * LOG2E, ln_); } while (0)
    const bf16* KCC = (const bf16*)(ws + WS_KCC) + (size_t)((b * 2 + gq) * 128) * 192; const bf16* VCC = (const bf16*)(ws + WS_VCC) + (size_t)((b * 2 + gq) * 128) * 128;
    const unsigned ctiles = cur >= 16 ? 3u : 1u;
    Stage<192, 1> stc; stc.load(KCC, 192, VCC, 128, nullptr, nullptr, (ctiles & 2u) ? 1 : 0, tid);
    ATT_LOADQ(nullptr);
    Ctx c; c.sl = exp2f(-(float)(h + 1)) * LOG2E; c.cf = nullptr; c.rk = nullptr; c.cref = 0.f; c.q0 = q0;
    c.tq0 = q0 + rbase + i16; c.selm[0] = 0u; c.selm[1] = 0u;
    LAS float* IMP = (LAS float*)(lds + LDS_IMP); LAS float* TOT = (LAS float*)(lds + LDS_TOT); LAS unsigned* SEL = (LAS unsigned*)(lds + LDS_SEL);
    if (tid < 64) SEL[tid] = 0u;
    LAS float* GLG = (LAS float*)(lds + LDS_GATE) + wave * 128;
    { int ln_ = lane; asm volatile("" : "+v"(ln_));
      if (ln_ < 32) { const float* gp = (const float*)(ws + WS_SMALL) + (rowb + q0 + rbase + ln_) * 32 + 8 + h * 3; GLG[ln_ * 4 + 0] = gp[0]; GLG[ln_ * 4 + 1] = gp[1]; GLG[ln_ * 4 + 2] = gp[2]; } }
    f32x4 O[2][8]; float m[2], l[2];
#define ATT_RESET() do { _Pragma("unroll") for (int qg = 0; qg < 2; ++qg) { m[qg] = -INFINITY; l[qg] = 0.f; _Pragma("unroll") for (int db = 0; db < 8; ++db) O[qg][db] = (f32x4){0.f, 0.f, 0.f, 0.f}; } } while (0)
#define ATT_FOLD(br, first) do { int ln_ = lane; asm volatile("" : "+v"(ln_));        \
    _Pragma("unroll") for (int qg = 0; qg < 2; ++qg) { const float lt = gsum(l[qg]); \
        const size_t row_ = rowb + q0 + rbase + 16 * qg + (ln_ & 15); \
        const float gl_ = GLG[(16 * qg + (ln_ & 15)) * 4 + (br)]; \
        const float wgt = lt > 0.f ? 1.f / ((1.f + __expf(-gl_)) * lt) : 0.f; \
        bf16* orow = (bf16*)(ws + WS_OAB) + row_ * 2048 + 1024 + h * 128 + 4 * (ln_ >> 4); \
        _Pragma("unroll") for (int db = 0; db < 8; ++db) { f32x4 o = O[qg][db] * wgt; \
            if (!(first)) { const u32x2 pv = *(const u32x2*)(orow + 16 * db); o[0] += ulo(pv.x); o[1] += uhi(pv.x); o[2] += ulo(pv.y); o[3] += uhi(pv.y); } \
            *(u32x2*)(orow + 16 * db) = (u32x2){cvtpk(o[0], o[1]), cvtpk(o[2], o[3])}; } } } while (0)
    ATT_RESET();
    branch<192, 1>(lds, ctiles, 3u, 0u, KCC, 192, VCC, 128, Q, O, m, l, c, tid, lane, stc, true);
    ATT_FOLD(0, true);
    Stage<192, 2> sts;
    c.rk = (const float*)(ws + WS_SSQ) + (size_t)(8 + gq) * MTOK + rowb;
    sts.load((const bf16*)(ws + WS_KS) + rowb * 384 + gq * 192, 384, (const bf16*)(ws + WS_VS) + rowb * 256 + gq * 128, 256, nullptr, c.rk, cur, tid);
    {
        float invl[2], mr[2];
#pragma unroll
        for (int qg = 0; qg < 2; ++qg) { const float lt = gsum(l[qg]); invl[qg] = lt > 0.f ? 1.f / lt : 0.f; mr[qg] = (m[qg] == -INFINITY) ? 0.f : m[qg]; }
        float carry[2] = {0.f, 0.f};
        int ln2 = lane; asm volatile("" : "+v"(ln2));
        LAS float* improw = IMP + ((hh * 64) + rbase + (ln2 & 15)) * 32 + (ln2 >> 4);
#pragma unroll
        for (int tt = 0; tt < 2; ++tt)
#pragma unroll
            for (int hf = 0; hf < 2; ++hf) {
                f32x4 S[2][2];
                if (tt == 0 || (ctiles & 2u)) qk_half<192, 1>(S, lds + (((ctiles & 2u) ? (tt == 0) : false) ? LDS_K1 : LDS_K0), nullptr, Q, c, tt, hf, true, lane);
                else {
#pragma unroll
                    for (int qg = 0; qg < 2; ++qg)
#pragma unroll
                        for (int k2 = 0; k2 < 2; ++k2) S[qg][k2] = (f32x4){-INFINITY, -INFINITY, -INFINITY, -INFINITY};
                }
#pragma unroll
                for (int qg = 0; qg < 2; ++qg) {
                    float xprev = carry[qg];
#pragma unroll
                    for (int k2 = 0; k2 < 2; ++k2) {
                        float pr[4];
#pragma unroll
                        for (int r = 0; r < 4; ++r) pr[r] = __builtin_amdgcn_exp2f(S[qg][k2][r] - mr[qg]) * invl[qg];
                        const float up = __shfl(pr[3], (lane + 48) & 63);
                        const float wrap = __shfl(xprev, (lane + 48) & 63);
                        const float prev = g == 0 ? wrap : up;
                        improw[16 * qg * 32 + 16 * tt + 4 * (2 * hf + k2)] = 2.f * (pr[0] + pr[1] + pr[2]) + pr[3] + prev;
                        xprev = pr[3];
                    }
                    carry[qg] = xprev;
                }
            }
    }
    __syncthreads();
    {
        int tid2 = tid; asm volatile("" : "+v"(tid2));
        const int t = tid2 >> 3, jq = tid2 & 7;
#pragma unroll
        for (int e = 0; e < 4; ++e) { const int j = 4 * jq + e;
            const float im = (IMP[(0 * 64 + t) * 32 + j] + IMP[(1 * 64 + t) * 32 + j]) + (IMP[(2 * 64 + t) * 32 + j] + IMP[(3 * 64 + t) * 32 + j]);
            const bool elig = j <= cur, forced = (j == 0) || (elig && (cur - j) < 2);
            TOT[t * 32 + j] = elig ? (forced ? 1.0e4f : im) : -1.f; }
        __syncthreads();
        unsigned bits = 0u;
#pragma unroll
        for (int e = 0; e < 4; ++e) { const int j = 4 * jq + e; const float sj = TOT[t * 32 + j]; int rank = 0;
#pragma unroll 4
            for (int j2 = 0; j2 < 32; ++j2) { const float s2 = TOT[t * 32 + j2]; rank += (s2 > sj || (s2 == sj && j2 < j)) ? 1 : 0; }
            if (rank < 16 && sj >= 0.f) bits |= 1u << j; }
        if (bits) atomicOr((unsigned*)(SEL + t), bits);
        __syncthreads();
    }
    c.selm[0] = SEL[rbase + i16]; c.selm[1] = SEL[rbase + 16 + i16];
    unsigned U = SEL[lane];
#pragma unroll
    for (int o = 32; o > 0; o >>= 1) U |= __shfl_xor(U, o);
    U = __builtin_amdgcn_readfirstlane(U);
    ATT_RESET();
    { unsigned wand = c.selm[0] & c.selm[1], wor = c.selm[0] | c.selm[1];
#pragma unroll
      for (int o = 1; o < 16; o <<= 1) { wand &= __shfl_xor(wand, o); wor |= __shfl_xor(wor, o); }
      wand = __builtin_amdgcn_readfirstlane(wand); wor = __builtin_amdgcn_readfirstlane(wor);
      branch<192, 2>(lds, U, ~wand | (1u << cur), ~wor, (const bf16*)(ws + WS_KS) + rowb * 384 + gq * 192, 384, (const bf16*)(ws + WS_VS) + rowb * 256 + gq * 128, 256, Q, O, m, l, c, tid, lane, sts, true); }
    Stage<192, 3> stw;
    c.rk = (const float*)(ws + WS_SSQ) + (size_t)(10 + gq) * MTOK + rowb;
    stw.load((const bf16*)(ws + WS_KW) + rowb * 384 + gq * 192, 384, (const bf16*)(ws + WS_VW) + rowb * 256 + gq * 128, 256, nullptr, c.rk, cur, tid);
    ATT_FOLD(1, false);
    ATT_RESET();
    { const int jlo = cur >= 8 ? cur - 8 : 0; const unsigned hi_m = cur >= 31 ? 0xffffffffu : ((1u << (cur + 1)) - 1u); const unsigned wt = hi_m & ~((1u << jlo) - 1u);
      branch<192, 3>(lds, wt, (1u << cur) | (cur >= 8 ? (1u << (cur - 8)) : 0u), 0u, (const bf16*)(ws + WS_KW) + rowb * 384 + gq * 192, 384, (const bf16*)(ws + WS_VW) + rowb * 256 + gq * 128, 256, Q, O, m, l, c, tid, lane, stw, true); }
    unsigned nxt = 0u;
    { int t0 = tid; asm volatile("" : "+v"(t0)); if (t0 == 0) nxt = __hip_atomic_fetch_add(qctr, 1u, __ATOMIC_RELAXED, __HIP_MEMORY_SCOPE_AGENT); }
    ATT_FOLD(2, false);
    { int t0 = tid; asm volatile("" : "+v"(t0)); if (t0 == 0) qslot[0] = nxt; }
#undef ATT_RESET
#undef ATT_FOLD
#undef ATT_LOADQ
    __syncthreads();
}

__device__ const unsigned short ATT_ORDER[576] = {276,277,278,279,280,281,282,283,284,285,286,287,308,309,310,311,312,313,314,315,316,317,318,319,340,341,342,343,344,345,346,347,348,349,350,351,372,373,374,375,376,377,378,379,380,381,382,383,404,405,406,407,408,409,410,411,412,413,414,415,436,437,438,439,440,441,442,443,444,445,446,447,468,469,470,471,472,473,474,475,476,477,478,479,500,501,502,503,504,505,506,507,508,509,510,511,275,307,339,371,403,435,467,499,274,306,338,370,402,434,466,498,273,305,337,369,401,433,465,497,272,304,336,368,400,432,464,496,271,303,335,367,399,431,463,495,270,302,334,366,398,430,462,494,269,301,333,365,397,429,461,493,268,300,332,364,396,428,460,492,267,299,331,363,395,427,459,491,266,298,330,362,394,426,458,490,265,297,329,361,393,425,457,489,264,296,328,360,392,424,456,488,263,295,327,359,391,423,455,487,262,294,326,358,390,422,454,486,7,15,23,31,39,47,55,63,71,79,87,95,103,111,119,127,135,143,151,159,167,175,183,191,199,207,215,223,231,239,247,255,261,293,325,357,389,421,453,485,6,14,22,30,38,46,54,62,70,78,86,94,102,110,118,126,134,142,150,158,166,174,182,190,198,206,214,222,230,238,246,254,260,292,324,356,388,420,452,484,259,291,323,355,387,419,451,483,5,13,21,29,37,45,53,61,69,77,85,93,101,109,117,125,133,141,149,157,165,173,181,189,197,205,213,221,229,237,245,253,258,290,322,354,386,418,450,482,4,12,20,28,36,44,52,60,68,76,84,92,100,108,116,124,132,140,148,156,164,172,180,188,196,204,212,220,228,236,244,252,257,289,321,353,385,417,449,481,256,288,320,352,384,416,448,480,3,11,19,27,35,43,51,59,67,75,83,91,99,107,115,123,131,139,147,155,163,171,179,187,195,203,211,219,227,235,243,251,512,513,514,515,516,517,518,519,520,521,522,523,524,525,526,527,528,529,530,531,532,533,534,535,536,537,538,539,540,541,542,543,544,545,546,547,548,549,550,551,552,553,554,555,556,557,558,559,560,561,562,563,564,565,566,567,568,569,570,571,572,573,574,575,2,10,18,26,34,42,50,58,66,74,82,90,98,106,114,122,130,138,146,154,162,170,178,186,194,202,210,218,226,234,242,250,1,9,17,25,33,41,49,57,65,73,81,89,97,105,113,121,129,137,145,153,161,169,177,185,193,201,209,217,225,233,241,249,0,8,16,24,32,40,48,56,64,72,80,88,96,104,112,120,128,136,144,152,160,168,176,184,192,200,208,216,224,232,240,248};

__device__ __forceinline__ void attn_phase(const Params& p, LAS unsigned char* lds, int vcu, int G, int tid, int wave, int lane) {
    unsigned* qctr = (unsigned*)(p.ws + WS_CTL) + 64;
    volatile LAS unsigned* qw = (volatile LAS unsigned*)(lds + LDS_QW);
    bool have = false;
    for (;;) {
        if (!have && tid == 0) qw[0] = __hip_atomic_fetch_add(qctr, 1u, __ATOMIC_RELAXED, __HIP_MEMORY_SCOPE_AGENT);
        __syncthreads();
        const unsigned slot = __builtin_amdgcn_readfirstlane(qw[0]);
        __syncthreads();
        if (slot >= 576u) break;
        const int id = ATT_ORDER[slot];
        have = id < 512;
        if (id < 256) fox_unit(p, lds, id >> 6, (id >> 3) & 7, id & 7, tid, wave, lane, qctr, qw);
        else if (id < 512) { const int v = id - 256; nsa_unit(p, lds, v >> 6, (v >> 5) & 1, v & 31, tid, wave, lane, qctr, qw); }
        else {
            pg8::Gemm g{(const bf16*)(p.ws + WS_XN), (const bf16*)(p.ws + WS_WIN), 2048, 2048, 2048};
            pg8::Gemm1Order S; S.so.init(MTOK, 10240, G, 0); S.tail = 1; S.tc = id - 512; S.Gt = 64;
            EpiProj E{p.ws, p.in[I_NSA_KS_GAIN], p.in[I_NSA_KW_GAIN]};
            pg8::gemm_phase<EpiProj, pg8::Gemm1Order, true>(lds, g, S, E, wave);
            __syncthreads();
        }
    }
}
}

__global__ void __launch_bounds__(NTHREADS, 2) fwd(Params p) {
    extern __shared__ __attribute__((aligned(16))) unsigned char lds_raw[];
    LAS unsigned char* lds = (LAS unsigned char*)lds_raw;
    const int wave = __builtin_amdgcn_readfirstlane((int)threadIdx.x >> 6);
#define TID_ (wave * 64 + lane_id())
#define LANE_ (lane_id())
    const int G = gridDim.x, bx = blockIdx.x;
    const int vcu = (G % 8 == 0) ? (bx % 8) * (G / 8) + bx / 8 : bx;
    const int gw = vcu * NWAVES + wave, NGW = G * NWAVES;
    unsigned char* ws = p.ws;
    const int lo = p.ph_lo, hi = p.ph_hi;
#ifndef ONLY_PHASE
#define ONLY_PHASE -1
#endif
#define IN(k) ((ONLY_PHASE < 0 || ONLY_PHASE == (k)) && lo <= (k) && (k) < hi)
    cg::grid_group grid = cg::this_grid();
    volatile LAS unsigned* bst = (volatile LAS unsigned*)(lds + LDS_BYTES - 16);
    if (TID_ < 4) bst[TID_] = 0u;
    __syncthreads();
    XcdBarrier xbar = xcd_barrier_post((unsigned*)(ws + WS_CTL) + 4096, bst, wave);
    if (p.ph_lo < 0) grid.sync();
#define SEAM(k) do { if (IN(k) && IN((k) + 1)) xcd_barrier(xbar); } while (0)
    if (IN(PH_P0)) { phase_p0(p, lds, gw, NGW, wave, LANE_); }
    SEAM(PH_P0);
    if (IN(PH_GEMM1)) {
        pg8::Gemm g{(const bf16*)(ws + WS_XN), (const bf16*)(ws + WS_WIN), 2048, 2048, 2048};
        pg8::Gemm1Order S; S.so.init(MTOK, 10240, G, bx); S.tail = 0; S.tc = 0; S.Gt = 1;
        EpiProj E{ws, p.in[I_NSA_KS_GAIN], p.in[I_NSA_KW_GAIN]};
        pg8::gemm_phase<EpiProj, pg8::Gemm1Order, true>(lds, g, S, E, wave);
    }
    SEAM(PH_GEMM1);
    if (IN(PH_P2A)) {
        if (bx == 200) {
            const int t_ = TID_; const bool isv = t_ >= 256; const int n = t_ & 255, nbp = isv ? 64 : 96;
            const float* bp = (const float*)(ws + (isv ? WS_BPV : WS_BPK)); float s0 = 0.f, s1 = 0.f, s2 = 0.f, s3 = 0.f;
            for (int i = 0; i < nbp; i += 16) { float t[16];
#pragma unroll
                for (int e = 0; e < 16; ++e) t[e] = bp[(i + e) * 256 + n];
#pragma unroll
                for (int e = 0; e < 16; e += 4) { s0 += t[e]; s1 += t[e + 1]; s2 += t[e + 2]; s3 += t[e + 3]; } }
            ((float*)(ws + WS_BIAS))[(isv ? 256 : 0) + n] = (s0 + s1) + (s2 + s3);
        }
        phase_cumsum(p, (G - 1 - vcu) * NWAVES + wave, NGW, LANE_);
        if (G == 256) {
            if ((bx >= 48 && bx < 128) || bx >= 160) { const int ci = (bx < 128 ? bx - 48 : bx - 80) * NWAVES + wave;
                phase_mix_weights(p, lds, ci, 176 * NWAVES, wave, LANE_); phase_ffn_weights(p, lds, ci, 176 * NWAVES, wave, LANE_, 0, CONV_GU_SPLIT); }
            else if (bx < 48 || bx >= 128) phase_ffn_weights(p, lds, (bx < 48 ? bx : bx - 80) * NWAVES + wave, 80 * NWAVES, wave, LANE_, CONV_GU_SPLIT, 11264);
        } else { phase_mix_weights(p, lds, gw, NGW, wave, LANE_); phase_ffn_weights(p, lds, gw, NGW, wave, LANE_, 0, 11264 + 5632); }

        __syncthreads();
        { pg8::Gemm g{(const bf16*)(ws + WS_KC), (const bf16*)(ws + WS_CW1K), 3072, 6144, KSLICE}; pg8::SplitOrder S{4, KS_K, G, bx};
          EpiSlab E{(float*)(ws + WS_HSLK)}; pg8::gemm_phase<EpiSlab, pg8::SplitOrder, false>(lds, g, S, E, wave); }
        { pg8::Gemm g{(const bf16*)(ws + WS_VC), (const bf16*)(ws + WS_CW1V), 2048, 4096, KSLICE}; pg8::SplitOrder S{4, KS_V, G, (bx + G / 2) % G};
          EpiSlab E{(float*)(ws + WS_HSLV)}; pg8::gemm_phase<EpiSlab, pg8::SplitOrder, false>(lds, g, S, E, wave); }

    }
    SEAM(PH_P2A);
    if (IN(PH_P2B)) {
        for (int u = bx; u < 256; u += G) cmp_finish_unit(p, lds, u, TID_);
    }
    SEAM(PH_P2B);
    if (IN(PH_ATTN)) { __syncthreads(); att::attn_phase(p, lds, vcu, G, TID_, wave, LANE_); }
    SEAM(PH_ATTN);
    if (IN(PH_MERGE)) {
        pg8::Gemm g{(const bf16*)(ws + WS_OAB), (const bf16*)(ws + WS_WU), 2048, 2048, 2048};
        pg8::StaticOrder S; S.init(MTOK, 2048, G, bx);
        EpiMerge E{(const bf16*)(ws + WS_GA), (const bf16*)(ws + WS_GB), (bf16*)(ws + WS_MERGED)};
        pg8::gemm_phase<EpiMerge, pg8::StaticOrder, false>(lds, g, S, E, wave);
    }
    SEAM(PH_MERGE);
    if (IN(PH_OUT)) {
        pg8::Gemm g{(const bf16*)(ws + WS_MERGED), (const bf16*)(ws + WS_WOUT), 2048, 2048, 2048};
        pg8::StaticOrder S; S.init(MTOK, 2048, G, bx);
        EpiOut E{p.in[I_X], p.out, (bf16*)(ws + WS_HB), (float*)(ws + WS_SUMSQ)};
        pg8::gemm_phase<EpiOut, pg8::StaticOrder, false>(lds, g, S, E, wave);
    }
    SEAM(PH_OUT);
    if (IN(PH_FFN)) {
        pg8::Gemm g{(const bf16*)(ws + WS_HB), (const bf16*)(ws + WS_WGU), 2048, 2048, 2048};
        pg8::StaticOrder S; S.init(MTOK, NGU, G, bx);
        EpiFfn E{(const float*)(ws + WS_SUMSQ), (bf16*)(ws + WS_ACT)};
        pg8::gemm_phase<EpiFfn, pg8::StaticOrder, true>(lds, g, S, E, wave);
        if (G == 256 && bx >= 128) phase_ffn_weights(p, lds, (bx - 128) * NWAVES + wave, 128 * NWAVES, wave, LANE_, 11264, 11264 + 5632);
    }
    SEAM(PH_FFN);
    if (IN(PH_DOWN)) {
        pg8::Gemm g{(const bf16*)(ws + WS_ACT), (const bf16*)(ws + WS_WD), DFF, DFF, DFF};
        pg8::StaticOrder S; S.init(MTOK, 2048, G, bx);
        EpiDown E{p.out, (const bf16*)(ws + WS_HB)};
        pg8::gemm_phase<EpiDown, pg8::StaticOrder, false>(lds, g, S, E, wave);
    }
#undef IN
#undef SEAM
#undef TID_
#undef LANE_
}

extern "C" void kernel_launch(void* const* d_in, const int* in_sizes, int n_in, void* d_out, int out_size, void* d_ws, size_t ws_size, hipStream_t stream) {
    static int grid = 0;
    if (grid == 0) {
        if (n_in != 23 || out_size != MTOK * DM || ws_size < WS_END) { fprintf(stderr, "kernel_launch: unexpected shapes / workspace (%d inputs, out %d, ws %zu < %zu)\n", n_in, out_size, ws_size, (size_t)WS_END); grid = -1; return; }
        int dev = 0, cus = 0;
        if (hipGetDevice(&dev) != hipSuccess || hipDeviceGetAttribute(&cus, hipDeviceAttributeMultiprocessorCount, dev) != hipSuccess) { grid = -1; return; }
        if (hipFuncSetAttribute((const void*)fwd, hipFuncAttributeMaxDynamicSharedMemorySize, LDS_BYTES) != hipSuccess) { fprintf(stderr, "kernel_launch: hipFuncSetAttribute failed\n"); grid = -1; return; }
        int per_cu = 0;
        if (hipOccupancyMaxActiveBlocksPerMultiprocessor(&per_cu, (const void*)fwd, NTHREADS, LDS_BYTES) != hipSuccess || per_cu < 1) { fprintf(stderr, "kernel_launch: occupancy query says %d blocks/CU\n", per_cu); grid = -1; return; }
        grid = cus;
    }
    if (grid < 0) return;
    (void)hipMemsetAsync((char*)d_ws + WS_CTL, 0, 32 * 1024, stream);
    Params p{};
    for (int i = 0; i < 23; ++i) p.in[i] = (const float*)d_in[i];
    p.out = (float*)d_out; p.ws = (unsigned char*)d_ws;
    p.ph_lo = 0; p.ph_hi = PH_N;
    void* args[] = {&p};
    hipError_t e = hipLaunchCooperativeKernel((const void*)fwd, dim3(grid), dim3(NTHREADS), args, LDS_BYTES, stream);
    if (e != hipSuccess) fprintf(stderr, "cooperative launch failed: %s (grid %d)\n", hipGetErrorString(e), grid);
}
```

```cpp
#include <hip/hip_runtime.h>
#include <hip/hip_cooperative_groups.h>
#include <cstdio>
#include <cstdint>
#include <cmath>

#define LAS __attribute__((address_space(3)))
typedef unsigned short bf16;
typedef short bf16x8 __attribute__((ext_vector_type(8)));
typedef float f32x4 __attribute__((ext_vector_type(4)));
typedef unsigned u32x4 __attribute__((ext_vector_type(4)));
typedef unsigned u32x2 __attribute__((ext_vector_type(2)));

constexpr int BATCH = 4, SEQ = 2048, DM = 2048, MTOK = BATCH * SEQ;
constexpr int FH = 8, FD = 128;
constexpr int NHD = 8, NG = 2, HPG = 4, DK = 192, DV = 128;
constexpr int DFF = 5632, DIN = 10656, DINP = 10752, NGU = 2 * DFF;
constexpr int CROWS = 1024;
constexpr float EPS = 1e-6f;
constexpr int KS_K = 12, KS_V = 8, KSLICE = 512;

constexpr size_t MiB = 1u << 20;
constexpr size_t WS_CTL = 0;
constexpr size_t WS_SMALL = 1 * MiB;
constexpr size_t WS_CF = 2 * MiB;
constexpr size_t WS_KCC = WS_CF + 256 * 1024;
constexpr size_t WS_VCC = WS_KCC + 384 * 1024;
constexpr size_t WS_SUMSQ = WS_VCC + 256 * 1024;
constexpr size_t WS_BPK = WS_SUMSQ + 32 * 1024;
constexpr size_t WS_BPV = WS_BPK + 96 * 1024;
constexpr size_t WS_BIAS = WS_BPV + 64 * 1024;
constexpr size_t WS_SSQ = 3 * MiB + 256 * 1024;
constexpr size_t WS_WU = 4 * MiB;
constexpr size_t WS_WOUT = 12 * MiB;
constexpr size_t WS_CW1K = 20 * MiB;
constexpr size_t WS_CW1V = 23 * MiB;
constexpr size_t WS_WGU = 25 * MiB;
constexpr size_t WS_WD = 69 * MiB;
constexpr size_t WS_WIN = 51 * MiB;
constexpr size_t WS_XN = 93 * MiB;
constexpr size_t WS_FQ = 125 * MiB, WS_FK = 141 * MiB, WS_FV = 157 * MiB;
constexpr size_t WS_NQ = 173 * MiB;
constexpr size_t WS_KC = 197 * MiB;
constexpr size_t WS_KS = 204 * MiB, WS_KW = 210 * MiB;
constexpr size_t WS_VC = 216 * MiB;
constexpr size_t WS_VS = 221 * MiB, WS_VW = 225 * MiB;
constexpr size_t WS_MERGED = 125 * MiB;
constexpr size_t WS_ACT = 125 * MiB;
constexpr size_t WS_GA = 229 * MiB, WS_GB = 261 * MiB;
constexpr size_t WS_HB = 229 * MiB;
constexpr size_t WS_OAB = 293 * MiB;
constexpr size_t WS_HSLK = 293 * MiB;
constexpr size_t WS_HSLV = 305 * MiB;
constexpr size_t WS_END = 325 * MiB;

static_assert(WS_WIN + (size_t)10240 * 4096 == WS_WD + (size_t)2048 * 5632 * 2 && WS_WGU + (size_t)11264 * 4096 == WS_WD, "FFN weight area ends where the surviving w_in rows begin");
__device__ __forceinline__ float bf2f(bf16 u) { return __uint_as_float((unsigned)u << 16); }
__device__ __forceinline__ unsigned f2bf(float f) { unsigned u = __float_as_uint(f); return (u + 0x7fffu + ((u >> 16) & 1u)) >> 16; }
__device__ __forceinline__ unsigned pk2(float lo, float hi) { return f2bf(lo) | (f2bf(hi) << 16); }
__device__ __forceinline__ float wsum(float v) {
#pragma unroll
    for (int o = 32; o > 0; o >>= 1) v += __shfl_xor(v, o);
    return v;
}
__device__ __forceinline__ float wmaxf(float v) {
#pragma unroll
    for (int o = 32; o > 0; o >>= 1) v = fmaxf(v, __shfl_xor(v, o));
    return v;
}
#define LDS_WAIT() asm volatile("s_waitcnt lgkmcnt(0)" ::: "memory")
__device__ __forceinline__ int lane_id() { int l; asm volatile("v_mbcnt_lo_u32_b32 %0, -1, 0\n\tv_mbcnt_hi_u32_b32 %0, -1, %0" : "=v"(l)); return l; }

namespace cg = cooperative_groups;
namespace pg8 {
constexpr int BM = 256, BK = 64, HALF = 128, HTB = HALF * BK * 2, STAGE_BYTES = 8 * HTB, NXCD = 8, WGM = 8;
__host__ __device__ __forceinline__ int lds_byte(int r, int c) { const int st = (r >> 4) * 2 + (c >> 5), rr = r & 15, cc = c & 31, ob = rr * 64 + cc * 2; return st * 1024 + (ob ^ (((ob >> 9) & 1) << 5)); }
__host__ __device__ __forceinline__ void stage_rc(int b, int& R, int& C) { const int st = b / 1024, sb = b % 1024, swz = sb ^ (((sb >> 9) & 1) << 5); R = (st >> 1) * 16 + swz / 64; C = (st & 1) * 32 + (swz % 64) / 2; }
__host__ __device__ __forceinline__ int perm32(int rho) { const int n = rho >> 4, i = rho & 15; return 8 * (i >> 2) + 4 * n + (i & 3); }

struct Unit { int pm, pn, ks; };
struct Gemm { const bf16* A; const bf16* Bt; int lda, ldb, K; };

struct StaticOrder {
    int nM, nN, nwg, G, c;
    __host__ __device__ void init(int M, int N, int G_, int c_) { nM = M / BM; nN = N / BM; nwg = nM * nN; G = G_; c = c_; }
    __host__ __device__ bool next(int i, Unit& u) const {
        const long L = (long)i * G + c; if (L >= nwg) return false;
        int wgid = (int)L; { const int q = nwg / NXCD, r = nwg % NXCD, xcd = wgid % NXCD, off = wgid / NXCD; wgid = (xcd < r ? xcd * (q + 1) : r * (q + 1) + (xcd - r) * q) + off; }
        const int nig = WGM * nN, gid = wgid / nig, fm = gid * WGM, gsz = (nM - fm) < WGM ? (nM - fm) : WGM;
        u.pm = fm + ((wgid % nig) % gsz); u.pn = (wgid % nig) / gsz; u.ks = 0; return true;
    }
    __device__ __forceinline__ void done(int) const {}
};
struct SplitOrder {
    int nM, nKS, G, c;
    __host__ __device__ bool next(int i, Unit& u) const { const long L = (long)i * G + c; if (L >= (long)nM * nKS) return false; u.pm = (int)(L % nM); u.pn = 0; u.ks = (int)(L / nM); return true; }
    __device__ __forceinline__ void done(int) const {}
};
struct Gemm1Order {
    StaticOrder so; int tail, tc, Gt;
    __device__ bool next(int i, Unit& u) const {
        if (!tail) return so.next(i, u);
        const long L = (long)i * Gt + tc; if (L >= 64) return false;
        u.pm = (int)(L >> 1); u.pn = 40 + (int)(L & 1); u.ks = 0; return true;
    }
    __device__ __forceinline__ void done(int) const {}
};

template <class Epi, class Sched, bool ALIGN_EPI>
__device__ __forceinline__ void gemm_phase(LAS unsigned char* lds, const Gemm g, const Sched& S, const Epi& E, int wid) {
    int lane_ = lane_id(); asm volatile("" : "+v"(lane_));
    const int lane = lane_, tid = wid * 64 + lane, wr = wid >> 2, wc = wid & 3, fr = lane & 15, fq = lane >> 4;
    const int K = g.K, nt = K / BK;
    unsigned voffA[2], voffB[2];
#pragma unroll
    for (int i = 0; i < 2; ++i) { int R, C; stage_rc(tid * 16 + i * 8192, R, C); const int Rb = Epi::PERM ? ((R & ~31) + perm32(R & 31)) : R;
        voffA[i] = (unsigned)(R * g.lda + C) * 2u; voffB[i] = (unsigned)(Rb * g.ldb + C) * 2u; }
    const size_t kstep = (size_t)(BK * 2);
    const size_t hA = (size_t)HALF * g.lda * 2, hB = (size_t)HALF * g.ldb * 2;
    const unsigned ldsw = (unsigned)wid * 1024u;
    const int aoff = lds_byte(wr * 64 + fr, fq * 8), boff = lds_byte(wc * 32 + fr, fq * 8);
#define PG8_SA(b, h) (((b) * 2 + (h)) * HTB)
#define PG8_SB(b, h) ((4 + (b) * 2 + (h)) * HTB)
#define PG8_STAGE(bufoff, gbase, voff) do { _Pragma("unroll") for (int _i = 0; _i < 2; ++_i) \
        __builtin_amdgcn_global_load_lds((const unsigned*)((const char*)(gbase) + (voff)[_i]), (LAS unsigned*)(lds + (bufoff) + ldsw + _i * 8192), 16, 0, 0); } while (0)
#define PG8_LDA(dst, b, h) do { _Pragma("unroll") for (int m = 0; m < 4; ++m) _Pragma("unroll") for (int k = 0; k < 2; ++k) dst[m][k] = *(const LAS bf16x8*)(lds + PG8_SA(b, h) + aoff + m * 2048 + k * 1024); } while (0)
#define PG8_LDB(dst, b, h) do { _Pragma("unroll") for (int n = 0; n < 2; ++n) _Pragma("unroll") for (int k = 0; k < 2; ++k) dst[n][k] = *(const LAS bf16x8*)(lds + PG8_SB(b, h) + boff + n * 2048 + k * 1024); } while (0)
#define PG8_MMA(ai, bj, At, Bt) do { __builtin_amdgcn_s_setprio(1); _Pragma("unroll") for (int m = 0; m < 4; ++m) _Pragma("unroll") for (int n = 0; n < 2; ++n) _Pragma("unroll") for (int k = 0; k < 2; ++k) \
        acc[ai][bj][m][n] = __builtin_amdgcn_mfma_f32_16x16x32_bf16(Bt[n][k], At[m][k], acc[ai][bj][m][n], 0, 0, 0); __builtin_amdgcn_s_setprio(0); } while (0)
#define PG8_WAIT_V(n) asm volatile("s_waitcnt vmcnt(" #n ")" ::: "memory")
#define PG8_WAIT_L(n) asm volatile("s_waitcnt lgkmcnt(" #n ")" ::: "memory")
#define PG8_BAR __builtin_amdgcn_s_barrier()
#define PG8_SCHED __builtin_amdgcn_sched_barrier(0)
    Unit cur, nxt; int ui = 0;
    if (!S.next(0, cur)) return;
    f32x4 acc[2][2][4][2];
#pragma unroll
    for (int a = 0; a < 2; ++a)
#pragma unroll
        for (int b = 0; b < 2; ++b)
#pragma unroll
            for (int m = 0; m < 4; ++m)
#pragma unroll
                for (int n = 0; n < 2; ++n) acc[a][b][m][n] = (f32x4){0.f, 0.f, 0.f, 0.f};
    bf16x8 At[4][2], B0[2][2], B1[2][2];
    const char* cA = (const char*)g.A + ((size_t)cur.pm * BM * g.lda + (size_t)cur.ks * K) * 2;
    const char* cB = (const char*)g.Bt + ((size_t)cur.pn * BM * g.ldb + (size_t)cur.ks * K) * 2;
    PG8_STAGE(PG8_SB(0, 0), cB, voffB); PG8_STAGE(PG8_SB(0, 1), cB + hB, voffB); PG8_STAGE(PG8_SA(0, 0), cA, voffA); PG8_STAGE(PG8_SA(0, 1), cA + hA, voffA);
    if (wr == 1) PG8_BAR;
    PG8_WAIT_V(2); PG8_BAR;
    PG8_STAGE(PG8_SB(1, 0), cB + kstep, voffB); PG8_STAGE(PG8_SA(1, 0), cA + kstep, voffA); PG8_STAGE(PG8_SB(1, 1), cB + hB + kstep, voffB);
    if constexpr (Epi::HAS_PREFETCH) E.prefetch(cur, wr, wc, fr, fq, lds + STAGE_BYTES + 1024 + wid * 1024);
    PG8_WAIT_V(6); PG8_BAR;
    for (;;) {
        const bool has_next = S.next(ui + 1, nxt);
        const char* nA = has_next ? (const char*)g.A + ((size_t)nxt.pm * BM * g.lda + (size_t)nxt.ks * K) * 2 : cA;
        const char* nB = has_next ? (const char*)g.Bt + ((size_t)nxt.pn * BM * g.ldb + (size_t)nxt.ks * K) * 2 : cB;
        for (int t = 0; t < nt; t += 2) {
            const bool last = (t == nt - 2);
            const char* a1 = cA + (size_t)(t + 1) * kstep;
            const char* a2 = last ? nA : cA + (size_t)(t + 2) * kstep; const char* b2 = last ? nB : cB + (size_t)(t + 2) * kstep;
            const char* a3 = a2 + kstep; const char* b3 = b2 + kstep;
            PG8_LDB(B0, 0, 0); PG8_LDB(B1, 0, 1); PG8_SCHED; PG8_LDA(At, 0, 0); PG8_STAGE(PG8_SA(1, 1), a1 + hA, voffA);
            PG8_WAIT_V(8); PG8_WAIT_L(0); PG8_BAR; PG8_MMA(0, 0, At, B0); PG8_MMA(0, 1, At, B1); PG8_BAR; PG8_SCHED;
            PG8_LDA(At, 0, 1); PG8_STAGE(PG8_SB(0, 0), b2, voffB); PG8_STAGE(PG8_SB(0, 1), b2 + hB, voffB); PG8_STAGE(PG8_SA(0, 0), a2, voffA);
            PG8_WAIT_V(8); PG8_WAIT_L(0); PG8_BAR; PG8_MMA(1, 0, At, B0); PG8_MMA(1, 1, At, B1); PG8_BAR; PG8_SCHED;
            PG8_LDB(B0, 1, 0); PG8_LDB(B1, 1, 1); PG8_SCHED; PG8_LDA(At, 1, 0); PG8_STAGE(PG8_SA(0, 1), a2 + hA, voffA);
            PG8_WAIT_V(8); PG8_WAIT_L(0); PG8_BAR; PG8_MMA(0, 0, At, B0); PG8_MMA(0, 1, At, B1); PG8_BAR; PG8_SCHED;
            PG8_LDA(At, 1, 1); PG8_STAGE(PG8_SB(1, 0), b3, voffB); PG8_STAGE(PG8_SB(1, 1), b3 + hB, voffB); PG8_STAGE(PG8_SA(1, 0), a3, voffA);
            PG8_WAIT_V(8); PG8_WAIT_L(0); PG8_BAR; PG8_MMA(1, 0, At, B0); PG8_MMA(1, 1, At, B1); PG8_BAR; PG8_SCHED;
            if constexpr (Epi::HAS_MID) { if (t + 2 == (nt >> 1)) E.mid(acc, cur, wr, wc, fr, fq); }
        }
        if constexpr (ALIGN_EPI) { if (wr == 0) PG8_BAR; }
        E(acc, cur, wr, wc, fr, fq);
        S.done(ui);
        if (!has_next) break;
#pragma unroll
        for (int a = 0; a < 2; ++a)
#pragma unroll
            for (int b = 0; b < 2; ++b)
#pragma unroll
                for (int m = 0; m < 4; ++m)
#pragma unroll
                    for (int n = 0; n < 2; ++n) acc[a][b][m][n] = (f32x4){0.f, 0.f, 0.f, 0.f};
        cur = nxt; cA = nA; cB = nB; ++ui;
        if constexpr (ALIGN_EPI) { if (wr == 1) PG8_BAR; }
    }
    PG8_WAIT_V(0);
    if constexpr (!ALIGN_EPI) { if (wr == 0) PG8_BAR; }
    PG8_BAR;
#undef PG8_SA
#undef PG8_SB
#undef PG8_STAGE
#undef PG8_LDA
#undef PG8_LDB
#undef PG8_MMA
#undef PG8_WAIT_V
#undef PG8_WAIT_L
#undef PG8_BAR
#undef PG8_SCHED
}
}


#define XB_TMO      128
#define XB_XCNT(j)  (256  + 64 * (j))
#define XB_XSUB(j)  (1280 + 64 * (j))
#define XB_XGEN(j)  (2304 + 64 * (j))
#define XB_TOP      3328
#define XB_TOPGEN   3392
#define XCD_BAR_WORDS 3456
#define XB_SPIN_CAP (1u << 18)
__device__ __forceinline__ unsigned xb_ld(unsigned* p)              { return __hip_atomic_load(p, __ATOMIC_RELAXED, __HIP_MEMORY_SCOPE_AGENT); }
__device__ __forceinline__ unsigned xb_add(unsigned* p, unsigned v) { return __hip_atomic_fetch_add(p, v, __ATOMIC_RELAXED, __HIP_MEMORY_SCOPE_AGENT); }
__device__ __forceinline__ unsigned xb_xcc_id() { return (unsigned)__builtin_amdgcn_s_getreg((3 << 11) | 20) & 0xFu; }
#define XB_SPIN(cond, bar) do { unsigned _sp = 0; while (cond) { __builtin_amdgcn_s_sleep(1); \
    if ((++_sp & 255u) == 0u) { if (xb_ld(&(bar)[XB_TMO])) break; if (_sp > XB_SPIN_CAP) { atomicAdd(&(bar)[XB_TMO], 1u); break; } } } } while (0)
struct XcdBarrier { unsigned* bar; unsigned x; volatile LAS unsigned* st; int wave; };
__device__ __forceinline__ XcdBarrier xcd_barrier_post(unsigned* bar, volatile LAS unsigned* st, int wave) {
    XcdBarrier b; b.bar = bar; b.x = xb_xcc_id(); b.st = st; b.wave = wave;
    if (wave == 0 && lane_id() == 0) (void)xb_add(&bar[XB_XCNT(b.x)], 1u);
    return b;
}
__device__ __forceinline__ void xcd_barrier_complete(unsigned* bar, unsigned x, unsigned& nloc, unsigned& nx) {
    const unsigned G = gridDim.x * gridDim.y * gridDim.z;
    unsigned sum, cnt, mine, sp = 0u;
    for (;;) {
        sum = 0u; cnt = 0u; mine = 0u;
#pragma unroll
        for (unsigned j = 0; j < 16; ++j) { const unsigned c = xb_ld(&bar[XB_XCNT(j)]); sum += c; cnt += (c > 0u) ? 1u : 0u; mine = (j == x) ? c : mine; }
        if (sum == G) break;
        __builtin_amdgcn_s_sleep(1);
        if ((++sp & 255u) == 0u) { if (xb_ld(&bar[XB_TMO])) break; if (sp > XB_SPIN_CAP) { atomicAdd(&bar[XB_TMO], 1u); break; } }
    }
    nloc = mine > 0u ? mine : 1u; nx = cnt > 0u ? cnt : 1u;
}
__device__ __forceinline__ void xcd_barrier(const XcdBarrier& b) {
    asm volatile("s_waitcnt vmcnt(0)" ::: "memory");
    __syncthreads();
    if (b.wave == 0 && lane_id() == 0) {
        unsigned* bar = b.bar;
        __builtin_amdgcn_s_waitcnt(0);
        unsigned nloc = b.st[0], nx = b.st[1];
        if (nloc == 0u) { xcd_barrier_complete(bar, b.x, nloc, nx); b.st[0] = nloc; b.st[1] = nx; }
        const unsigned old = xb_add(&bar[XB_XSUB(b.x)], 1u);
        const unsigned gen = old / nloc;
        if (old + 1u == (gen + 1u) * nloc) {
            __builtin_amdgcn_fence(__ATOMIC_RELEASE, "agent");
            asm volatile("s_waitcnt vmcnt(0)" ::: "memory");
            const unsigned og = xb_add(&bar[XB_TOP], 1u);
            const unsigned tg = og / nx;
            if (og + 1u == (tg + 1u) * nx) xb_add(&bar[XB_TOPGEN], 1u);
            else XB_SPIN(xb_ld(&bar[XB_TOPGEN]) == tg, bar);
            __builtin_amdgcn_fence(__ATOMIC_ACQUIRE, "agent");
            xb_add(&bar[XB_XGEN(b.x)], 1u);
            asm volatile("s_waitcnt vmcnt(0)" ::: "memory");
        } else {
            XB_SPIN(xb_ld(&bar[XB_XGEN(b.x)]) == gen, bar);
            __builtin_amdgcn_fence(__ATOMIC_ACQUIRE, "agent");
            asm volatile("s_waitcnt vmcnt(0)" ::: "memory");
        }
    }
    __syncthreads();
}

struct Params {
    const float* in[23];
    float* out;
    unsigned char* ws;
    int ph_lo, ph_hi;
};
enum { I_X = 0, I_NORM_ATTN, I_W_IN, I_FOX_F_BIAS, I_FOX_Q_GAIN, I_FOX_K_GAIN, I_NSA_Q_GAIN, I_NSA_KC_GAIN, I_NSA_KS_GAIN, I_NSA_KW_GAIN,
       I_PE_K, I_W1_K, I_W2_K, I_PE_V, I_W1_V, I_W2_V, I_W_UP_FOX, I_W_UP_NSA, I_W_OUT, I_NORM_FFN, I_W_GATE, I_W_UP, I_W_DOWN };

typedef float f32x2_t_ __attribute__((ext_vector_type(2))); typedef __bf16 bf16x2_t_ __attribute__((ext_vector_type(2)));
__device__ __forceinline__ unsigned cvtpk2(float lo, float hi) { f32x2_t_ v = {lo, hi}; bf16x2_t_ b = __builtin_convertvector(v, bf16x2_t_); return __builtin_bit_cast(unsigned, b); }
__device__ __forceinline__ u32x4 pack8(const f32x4& a, const f32x4& b) { return (u32x4){cvtpk2(a[0], a[1]), cvtpk2(a[2], a[3]), cvtpk2(b[0], b[1]), cvtpk2(b[2], b[3])}; }
struct EpiProj {
    static constexpr bool PERM = true, HAS_MID = false, HAS_PREFETCH = false;
    unsigned char* ws; const float* ksg; const float* kwg;
    __device__ __forceinline__ void operator()(const f32x4 (&acc)[2][2][4][2], const pg8::Unit& u, int wr, int wc, int fr, int fq) const {
#pragma unroll
        for (int bj = 0; bj < 2; ++bj) {
            const int c0 = u.pn * 256 + bj * 128;
            int kind = 0, pitch = 0, coff = 0; size_t base = 0;
            const float* kg = nullptr;
            int slot = -1;
            if (c0 < 1024) { base = WS_FQ; pitch = 1024; coff = c0; }
            else if (c0 < 2048) { base = WS_FK; pitch = 1024; coff = c0 - 1024; slot = coff >> 7; }
            else if (c0 < 3072) { base = WS_FV; pitch = 1024; coff = c0 - 2048; }
            else if (c0 < 4608) { base = WS_NQ; pitch = 1536; coff = c0 - 3072; }
            else if (c0 < 4992) { kind = 1; coff = c0 - 4608; }
            else if (c0 < 5376) { base = WS_KS; pitch = 384; coff = c0 - 4992; slot = 8 + ((coff + wc * 32) >= 192 ? 1 : 0); kg = ksg; }
            else if (c0 < 5760) { base = WS_KW; pitch = 384; coff = c0 - 5376; slot = 10 + ((coff + wc * 32) >= 192 ? 1 : 0); kg = kwg; }
            else if (c0 < 6016) { kind = 2; coff = c0 - 5760; }
            else if (c0 < 6272) { base = WS_VS; pitch = 256; coff = c0 - 6016; }
            else if (c0 < 6528) { base = WS_VW; pitch = 256; coff = c0 - 6272; }
            else if (c0 < 6656) { kind = 3; }
            else if (c0 < 8704) { base = WS_GA; pitch = 2048; coff = c0 - 6656; }
            else { base = WS_GB; pitch = 2048; coff = c0 - 8704; }
            const int cw = wc * 32 + fq * 8;
            f32x4 kg0 = {1.f, 1.f, 1.f, 1.f}, kg1 = {1.f, 1.f, 1.f, 1.f};
            if (kg) { const int d = (coff + cw) % 192; kg0 = *(const f32x4*)(kg + d); kg1 = *(const f32x4*)(kg + d + 4); }
#pragma unroll
            for (int ai = 0; ai < 2; ++ai)
#pragma unroll
                for (int m = 0; m < 4; ++m) { const int row = u.pm * 256 + ai * 128 + wr * 64 + m * 16 + fr;
                    f32x4 v0 = acc[ai][bj][m][0], v1 = acc[ai][bj][m][1];
                    if (slot >= 0) {
                        float ss = ((v0[0] * v0[0] + v0[1] * v0[1]) + (v0[2] * v0[2] + v0[3] * v0[3])) + ((v1[0] * v1[0] + v1[1] * v1[1]) + (v1[2] * v1[2] + v1[3] * v1[3]));
                        ss += __shfl_xor(ss, 16); ss += __shfl_xor(ss, 32);
                        if (fq == 0) atomicAdd((float*)(ws + WS_SSQ) + (size_t)slot * MTOK + row, ss); }
                    if (kg) { v0 *= kg0; v1 *= kg1; }
                    if (kind == 3) { if (cw < 32) { float* sp = (float*)(ws + WS_SMALL) + (size_t)row * 32 + cw; *(f32x4*)sp = v0; *(f32x4*)(sp + 4) = v1; } continue; }
                    bf16* p;
                    if (kind == 0) p = (bf16*)(ws + base) + (size_t)row * pitch + coff + cw;
                    else if (kind == 1) { const int cc = coff + cw, g = cc >= 192 ? 1 : 0, d = cc - 192 * g; p = (bf16*)(ws + WS_KC) + ((size_t)(row + (row >> 11) * SEQ + g * SEQ)) * 192 + d; }
                    else { const int g = coff >> 7; p = (bf16*)(ws + WS_VC) + ((size_t)(row + (row >> 11) * SEQ + g * SEQ)) * 128 + cw; }
                    if (c0 >= 6656) __builtin_nontemporal_store(pack8(v0, v1), (u32x4*)p); else *(u32x4*)p = pack8(v0, v1); }
        }
    }
};
struct EpiSlab {
    static constexpr bool PERM = true, HAS_MID = false, HAS_PREFETCH = false;
    float* slab;
    __device__ __forceinline__ void operator()(const f32x4 (&acc)[2][2][4][2], const pg8::Unit& u, int wr, int wc, int fr, int fq) const {
#pragma unroll
        for (int ai = 0; ai < 2; ++ai)
#pragma unroll
            for (int m = 0; m < 4; ++m) { const int row = u.pm * 256 + ai * 128 + wr * 64 + m * 16 + fr; float* rp = slab + ((size_t)u.ks * CROWS + row) * 256 + wc * 32 + fq * 8;
#pragma unroll
                for (int bj = 0; bj < 2; ++bj) { *(f32x4*)(rp + bj * 128) = acc[ai][bj][m][0]; *(f32x4*)(rp + bj * 128 + 4) = acc[ai][bj][m][1]; } }
    }
};
__device__ __forceinline__ float clampf(float v, float lo, float hi) { return fminf(fmaxf(v, lo), hi); }
__device__ __forceinline__ float gl(unsigned w, int hi) { return clampf(__uint_as_float(hi ? (w & 0xffff0000u) : (w << 16)), -30.f, 30.f); }
#define EPI_ROW(gi) ((size_t)(u.pm * 256 + ((gi) >> 2) * 128 + wr * 64 + ((gi) & 3) * 16 + fr))
#define EPI_FENCE() asm volatile("" ::: "memory")
#define EPI_PF(ptr) __builtin_amdgcn_global_load_lds((const unsigned*)(ptr), (LAS unsigned*)junk, 16, 0, 0)
struct EpiMerge {
    static constexpr bool PERM = true, HAS_MID = true, HAS_PREFETCH = false;
    const bf16* GA; const bf16* GB; bf16* MG;
    __device__ __forceinline__ void prefetch(const pg8::Unit& u, int wr, int wc, int fr, int fq, LAS unsigned char* junk) const {
        const size_t cbase = (size_t)(u.pn * 256 + wc * 32 + fq * 8);
#pragma unroll
        for (int gi = 0; gi < 8; ++gi) { const size_t o_ = EPI_ROW(gi) * 2048 + cbase; EPI_PF(GA + o_); EPI_PF(GA + o_ + 128); EPI_PF(GB + o_); EPI_PF(GB + o_ + 128); }
    }
    __device__ __forceinline__ void mid(f32x4 (&acc)[2][2][4][2], const pg8::Unit& u, int wr, int wc, int fr, int fq) const {
        int zero; asm volatile("v_mov_b32 %0, 0" : "=v"(zero));
        const size_t cbase = (size_t)(u.pn * 256 + wc * 32 + fq * 8 + zero);
#pragma unroll
        for (int hf = 0; hf < 2; ++hf) {
            u32x4 a[8], b[8];
#pragma unroll
            for (int i = 0; i < 8; ++i) { const int st = 8 * hf + i; const size_t o_ = EPI_ROW(st >> 1) * 2048 + cbase + (st & 1) * 128; a[i] = *(const u32x4*)(GA + o_); b[i] = *(const u32x4*)(GB + o_); }
#pragma unroll
            for (int i = 0; i < 8; ++i) { const int st = 8 * hf + i;
#pragma unroll
                for (int e = 0; e < 8; ++e) { const float ga_ = gl(a[i][e >> 1], e & 1), gb_ = gl(b[i][e >> 1], e & 1);
                    acc[st >> 3][st & 1][(st >> 1) & 3][e >> 2][e & 3] *= (1.f + __expf(-gb_)) * __builtin_amdgcn_rcpf(1.f + __expf(-ga_)); } }
            EPI_FENCE();
        }
    }
    __device__ __forceinline__ void operator()(const f32x4 (&acc)[2][2][4][2], const pg8::Unit& u, int wr, int wc, int fr, int fq) const {
        const size_t cbase = (size_t)(u.pn * 256 + wc * 32 + fq * 8);
        u32x4 b0[2], b1[2];
#define MG_LDB(B, gi) do { const size_t o_ = EPI_ROW(gi) * 2048 + cbase; B[0] = *(const u32x4*)(GB + o_); B[1] = *(const u32x4*)(GB + o_ + 128); } while (0)
#define MG_FIN(B, gi) do { _Pragma("unroll") for (int bj = 0; bj < 2; ++bj) { f32x4 o0, o1; \
            _Pragma("unroll") for (int e = 0; e < 4; ++e) { o0[e] = acc[(gi) >> 2][bj][(gi) & 3][0][e] * __builtin_amdgcn_rcpf(1.f + __expf(-gl(B[bj][e >> 1], e & 1))); \
                                                            o1[e] = acc[(gi) >> 2][bj][(gi) & 3][1][e] * __builtin_amdgcn_rcpf(1.f + __expf(-gl(B[bj][2 + (e >> 1)], e & 1))); } \
            *(u32x4*)(MG + EPI_ROW(gi) * 2048 + cbase + bj * 128) = pack8(o0, o1); } } while (0)
        MG_LDB(b0, 0);
#pragma unroll
        for (int gi = 0; gi < 8; gi += 2) {
            MG_LDB(b1, gi + 1); MG_FIN(b0, gi); EPI_FENCE();
            if (gi + 2 < 8) MG_LDB(b0, gi + 2);
            MG_FIN(b1, gi + 1); EPI_FENCE();
        }
#undef MG_LDB
#undef MG_FIN
    }
};
struct EpiOut {
    static constexpr bool PERM = true, HAS_MID = false, HAS_PREFETCH = false;
    const float* x; float* out; bf16* HB; float* sumsq;
    __device__ __forceinline__ void prefetch(const pg8::Unit& u, int wr, int wc, int fr, int fq, LAS unsigned char* junk) const {
        const size_t cbase = (size_t)(u.pn * 256 + wc * 32 + fq * 8);
#pragma unroll
        for (int gi = 0; gi < 8; ++gi) { const float* p_ = x + EPI_ROW(gi) * 2048 + cbase; EPI_PF(p_); EPI_PF(p_ + 4); EPI_PF(p_ + 128); EPI_PF(p_ + 132); }
    }
    __device__ __forceinline__ void operator()(const f32x4 (&acc)[2][2][4][2], const pg8::Unit& u, int wr, int wc, int fr, int fq) const {
        const size_t cbase = (size_t)(u.pn * 256 + wc * 32 + fq * 8);
        f32x4 x0[4], x1[4];
#define EO_LD(X, gi) do { const float* p_ = x + EPI_ROW(gi) * 2048 + cbase; X[0] = *(const f32x4*)p_; X[1] = *(const f32x4*)(p_ + 4); X[2] = *(const f32x4*)(p_ + 128); X[3] = *(const f32x4*)(p_ + 132); } while (0)
#define EO_DO(X, gi) do { const size_t off_ = EPI_ROW(gi) * 2048 + cbase; float ss = 0.f; \
        _Pragma("unroll") for (int bj = 0; bj < 2; ++bj) { const f32x4 h0 = X[2 * bj] + acc[(gi) >> 2][bj][(gi) & 3][0], h1 = X[2 * bj + 1] + acc[(gi) >> 2][bj][(gi) & 3][1]; \
            ss += ((h0[0] * h0[0] + h0[1] * h0[1]) + (h0[2] * h0[2] + h0[3] * h0[3])) + ((h1[0] * h1[0] + h1[1] * h1[1]) + (h1[2] * h1[2] + h1[3] * h1[3])); \
            *(u32x4*)(HB + off_ + bj * 128) = pack8(h0, h1); } \
        ss += __shfl_xor(ss, 16); ss += __shfl_xor(ss, 32); if (fq == 0) atomicAdd(sumsq + EPI_ROW(gi), ss); } while (0)
        EO_LD(x0, 0);
#pragma unroll
        for (int gi = 0; gi < 8; gi += 2) {
            EO_LD(x1, gi + 1); EO_DO(x0, gi); EPI_FENCE();
            if (gi + 2 < 8) EO_LD(x0, gi + 2);
            EO_DO(x1, gi + 1); EPI_FENCE();
        }
#undef EO_LD
#undef EO_DO
    }
};
struct EpiFfn {
    static constexpr bool PERM = true, HAS_MID = false, HAS_PREFETCH = false;
    const float* sumsq; bf16* ACT;
    __device__ __forceinline__ void operator()(const f32x4 (&acc)[2][2][4][2], const pg8::Unit& u, int wr, int wc, int fr, int fq) const {
        float sq[8];
#pragma unroll
        for (int gi = 0; gi < 8; ++gi) sq[gi] = sumsq[EPI_ROW(gi)];
#pragma unroll
        for (int gi = 0; gi < 8; ++gi) { const int ai = gi >> 2, m = gi & 3;
            const float r = 1.0f / sqrtf(sq[gi] * (1.0f / DM) + EPS);
            f32x4 o[2];
#pragma unroll
            for (int n = 0; n < 2; ++n)
#pragma unroll
                for (int e = 0; e < 4; ++e) { const float gg = acc[ai][0][m][n][e] * r, uu = acc[ai][1][m][n][e] * r; o[n][e] = gg * __builtin_amdgcn_rcpf(1.f + __expf(-gg)) * uu; }
            *(u32x4*)(ACT + EPI_ROW(gi) * DFF + u.pn * 128 + wc * 32 + fq * 8) = pack8(o[0], o[1]); }
    }
};
struct EpiDown {
    static constexpr bool PERM = true, HAS_MID = false, HAS_PREFETCH = false;
    float* out; const bf16* HB;
    __device__ __forceinline__ void prefetch(const pg8::Unit& u, int wr, int wc, int fr, int fq, LAS unsigned char* junk) const {}
    __device__ __forceinline__ void operator()(const f32x4 (&acc)[2][2][4][2], const pg8::Unit& u, int wr, int wc, int fr, int fq) const {
        const size_t cbase = (size_t)(u.pn * 256 + wc * 32 + fq * 8);
        u32x4 x0[2], x1[2];
#define ED_LD(X, gi) do { const bf16* p_ = HB + EPI_ROW(gi) * 2048 + cbase; X[0] = *(const u32x4*)p_; X[1] = *(const u32x4*)(p_ + 128); } while (0)
#define ED_LO(w) __uint_as_float((w) << 16)
#define ED_HI(w) __uint_as_float((w) & 0xffff0000u)
#define ED_DO(X, gi) do { float* p_ = out + EPI_ROW(gi) * 2048 + cbase; \
        _Pragma("unroll") for (int bj = 0; bj < 2; ++bj) { \
            const f32x4 r0 = {ED_LO(X[bj].x), ED_HI(X[bj].x), ED_LO(X[bj].y), ED_HI(X[bj].y)}, r1 = {ED_LO(X[bj].z), ED_HI(X[bj].z), ED_LO(X[bj].w), ED_HI(X[bj].w)}; \
            __builtin_nontemporal_store(r0 + acc[(gi) >> 2][bj][(gi) & 3][0], (f32x4*)(p_ + bj * 128)); \
            __builtin_nontemporal_store(r1 + acc[(gi) >> 2][bj][(gi) & 3][1], (f32x4*)(p_ + bj * 128 + 4)); } } while (0)
        ED_LD(x0, 0);
#pragma unroll
        for (int gi = 0; gi < 8; gi += 2) {
            ED_LD(x1, gi + 1); ED_DO(x0, gi); EPI_FENCE();
            if (gi + 2 < 8) ED_LD(x0, gi + 2);
            ED_DO(x1, gi + 1); EPI_FENCE();
        }
#undef ED_LD
#undef ED_DO
#undef ED_LO
#undef ED_HI
    }
};

__device__ __forceinline__ int win_src(int n) {
    if (n < 3072) return n;
    if (n < 4608) return n + 8;
    if (n < 4992) return 4616 + (n - 4608);
    if (n < 5376) return 5256 + (n - 4992);
    if (n < 5760) return 5896 + (n - 5376);
    if (n < 6016) return 5000 + (n - 5760);
    if (n < 6272) return 5640 + (n - 6016);
    if (n < 6528) return 6280 + (n - 6272);
    if (n < 6536) return 3072 + (n - 6528);
    if (n < 6560) return n;
    if (n < 6656) return -1;
    if (n < 8704) return 6560 + (n - 6656);
    return 8608 + (n - 8704);
    return -1;
}
struct TrDesc { const float* src; const float* gain; bf16* dst; int nsrc; int ldT; int valid; };
template <int MAP> __device__ __forceinline__ TrDesc tr_desc(const float* W, const float* W2, int Nsrc, bf16* WT, int ldT, int kdst, const float* gain, int nbn, int item, int lane) {
    const int kb = item / nbn, nb = item - kb * nbn, k0 = 64 * kb, n0 = 32 * nb;
    const int nd = n0 + (lane & 31);
    const float* src = W; int col = nd;
    if (MAP == 1) col = win_src(nd);
    if (MAP == 2) { const int tile = nd >> 8, w = nd & 255; if (w < 128) col = tile * 128 + w; else { col = tile * 128 + w - 128; src = W2; } }
    TrDesc d; d.valid = col >= 0; d.src = src + (size_t)(k0 + (lane >> 5)) * Nsrc + (col >= 0 ? col : 0); d.gain = gain ? gain + k0 + (lane >> 5) : nullptr;
    d.dst = WT + (size_t)n0 * ldT + kdst + k0; d.nsrc = Nsrc; d.ldT = ldT; return d;
}
template <bool NT = false> __device__ __forceinline__ void tr_load(const TrDesc& d, float (&v)[32]) {
#pragma unroll
    for (int i = 0; i < 32; ++i) v[i] = d.valid ? (NT ? __builtin_nontemporal_load(d.src + (size_t)(2 * i) * d.nsrc) : d.src[(size_t)(2 * i) * d.nsrc]) : 0.f;
}
template <bool NT = false> __device__ __forceinline__ void tr_write(const TrDesc& d, const float (&v)[32], LAS float* scr, int lane) {
#pragma unroll
    for (int i = 0; i < 32; ++i) { const int kk = 2 * i + (lane >> 5); scr[kk * 33 + (lane & 31)] = d.gain ? v[i] * d.gain[2 * i] : v[i]; }
    LDS_WAIT();
    const int c = lane & 7;
#pragma unroll
    for (int j = 0; j < 4; ++j) { const int n = (lane >> 3) + 8 * j; const LAS float* s = scr + (8 * c) * 33 + n;
        u32x4 o; o.x = pk2(s[0 * 33], s[1 * 33]); o.y = pk2(s[2 * 33], s[3 * 33]); o.z = pk2(s[4 * 33], s[5 * 33]); o.w = pk2(s[6 * 33], s[7 * 33]);
        if (NT) __builtin_nontemporal_store(o, (u32x4*)(d.dst + (size_t)n * d.ldT + 8 * c)); else *(u32x4*)(d.dst + (size_t)n * d.ldT + 8 * c) = o; }
    LDS_WAIT();
}
template <bool NTW, class F> __device__ __forceinline__ void tr_pipeline3(F desc, int it0, int last, int stride, LAS float* scr, int lane) {
    float v0[32], v1[32], v2[32]; TrDesc d0, d1, d2;
    int a = it0;
    if (a < last) { d0 = desc(a); tr_load<true>(d0, v0); }
    if (a + stride < last) { d1 = desc(a + stride); tr_load<true>(d1, v1); }
    for (;;) {
        if (a >= last) break;
        if (a + 2 * stride < last) { d2 = desc(a + 2 * stride); tr_load<true>(d2, v2); }
        tr_write<NTW>(d0, v0, scr, lane);
        if (a + stride >= last) break;
        if (a + 3 * stride < last) { d0 = desc(a + 3 * stride); tr_load<true>(d0, v0); }
        tr_write<NTW>(d1, v1, scr, lane);
        if (a + 2 * stride >= last) break;
        if (a + 4 * stride < last) { d1 = desc(a + 4 * stride); tr_load<true>(d1, v1); }
        tr_write<NTW>(d2, v2, scr, lane);
        a += 3 * stride;
    }
}
__device__ __forceinline__ void xn_row(const float* xrow, const float* gain, bf16* orow, int lane) {
    const f32x4* xr = (const f32x4*)xrow + lane; const f32x4* gr = (const f32x4*)gain + lane;
    f32x4 v[8]; float s = 0.f;
#pragma unroll
    for (int j = 0; j < 8; ++j) { v[j] = xr[64 * j]; s += (v[j][0] * v[j][0] + v[j][1] * v[j][1]) + (v[j][2] * v[j][2] + v[j][3] * v[j][3]); }
    const float r = 1.0f / sqrtf(wsum(s) * (1.0f / DM) + EPS);
    unsigned long long* o8 = (unsigned long long*)orow + lane;
#pragma unroll
    for (int j = 0; j < 8; ++j) { const f32x4 g = gr[64 * j]; const f32x4 o = v[j] * r * g;
        o8[64 * j] = (unsigned long long)pk2(o[0], o[1]) | ((unsigned long long)pk2(o[2], o[3]) << 32); }
}

__device__ __forceinline__ void xn_row2(const float* xrow, const float* gain, bf16* orow, size_t stride, bool two, int lane) {
    const f32x4* xr = (const f32x4*)xrow + lane; const f32x4* gr = (const f32x4*)gain + lane;
    f32x4 v[8], v2[8]; float s = 0.f, s2 = 0.f;
#pragma unroll
    for (int j = 0; j < 8; ++j) { v[j] = __builtin_nontemporal_load(xr + 64 * j); v2[j] = two ? __builtin_nontemporal_load((const f32x4*)(xrow + stride) + lane + 64 * j) : (f32x4){0.f, 0.f, 0.f, 0.f}; }
#pragma unroll
    for (int j = 0; j < 8; ++j) { s += (v[j][0] * v[j][0] + v[j][1] * v[j][1]) + (v[j][2] * v[j][2] + v[j][3] * v[j][3]); s2 += (v2[j][0] * v2[j][0] + v2[j][1] * v2[j][1]) + (v2[j][2] * v2[j][2] + v2[j][3] * v2[j][3]); }
    const float r = 1.0f / sqrtf(wsum(s) * (1.0f / DM) + EPS), r2 = 1.0f / sqrtf(wsum(s2) * (1.0f / DM) + EPS);
    unsigned long long* o8 = (unsigned long long*)orow + lane; unsigned long long* o82 = (unsigned long long*)(orow + stride) + lane;
#pragma unroll
    for (int j = 0; j < 8; ++j) { const f32x4 g = gr[64 * j]; const f32x4 o = v[j] * r * g, o2 = v2[j] * r2 * g;
        o8[64 * j] = (unsigned long long)pk2(o[0], o[1]) | ((unsigned long long)pk2(o[2], o[3]) << 32);
        if (two) o82[64 * j] = (unsigned long long)pk2(o2[0], o2[1]) | ((unsigned long long)pk2(o2[2], o2[3]) << 32); }
}

constexpr int LDS_BYTES = 147456;
constexpr int NWAVES = 8, NTHREADS = 512;

enum { PH_P0 = 0, PH_GEMM1, PH_P2A, PH_P2B, PH_ATTN, PH_MERGE, PH_OUT, PH_FFN, PH_DOWN, PH_N };

__device__ __forceinline__ void phase_mix_weights(const Params& p, LAS unsigned char* lds, int cw, int NCW, int wave, int lane) {
    unsigned char* ws = p.ws;
    LAS float* scr = (LAS float*)(lds + wave * 16384);
    constexpr int I_WU = 16 * 64, I_WOUT = 32 * 64, NIT = 2 * I_WU + I_WOUT;
    auto desc = [&](int it) -> TrDesc {
        int r = it;
        if (r < I_WU) return tr_desc<0>(p.in[I_W_UP_FOX], nullptr, 2048, (bf16*)(ws + WS_WU), 2048, 0, nullptr, 64, r, lane);
        r -= I_WU;
        if (r < I_WU) return tr_desc<0>(p.in[I_W_UP_NSA], nullptr, 2048, (bf16*)(ws + WS_WU), 2048, 1024, nullptr, 64, r, lane);
        r -= I_WU;
        return tr_desc<0>(p.in[I_W_OUT], nullptr, 2048, (bf16*)(ws + WS_WOUT), 2048, 0, nullptr, 64, r, lane);
    };
    tr_pipeline3<false>(desc, cw, NIT, NCW, scr, lane);
}

__device__ __forceinline__ void phase_p0(const Params& p, LAS unsigned char* lds, int gw, int NGW, int wave, int lane) {
    unsigned char* ws = p.ws;
    LAS float* scr = (LAS float*)(lds + wave * 16384);
    constexpr int I_WIN = 32 * (DINP / 32), I_C1K = 96 * 8, I_C1V = 64 * 8;
    constexpr int NIT = I_WIN + I_C1K + I_C1V;
    auto desc = [&](int it) -> TrDesc {
        int r = it;
        if (r < I_WIN) return tr_desc<1>(p.in[I_W_IN], nullptr, DIN, (bf16*)(ws + WS_WIN), 2048, 0, nullptr, DINP / 32, r, lane);
        r -= I_WIN;
        if (r < I_C1K) return tr_desc<0>(p.in[I_W1_K], nullptr, 256, (bf16*)(ws + WS_CW1K), 6144, 0, nullptr, 8, r, lane);
        r -= I_C1K;
        return tr_desc<0>(p.in[I_W1_V], nullptr, 256, (bf16*)(ws + WS_CW1V), 4096, 0, nullptr, 8, r, lane);
    };
    {
        float va[32], vb[32]; TrDesc d, dn;
        int it = gw;
        if (it < NIT) { d = desc(it); tr_load<true>(d, va); }
        while (it < NIT) {
            const int itn = it + NGW;
            if (itn < NIT) { dn = desc(itn); tr_load<true>(dn, vb); }
            tr_write(d, va, scr, lane);
            it = itn; d = dn;
#pragma unroll
            for (int i = 0; i < 32; ++i) va[i] = vb[i];
        }
    }
    for (int m = gw; m < MTOK; m += 2 * NGW) xn_row2(p.in[I_X] + (size_t)m * DM, p.in[I_NORM_ATTN], (bf16*)(ws + WS_XN) + (size_t)m * DM, (size_t)NGW * DM, m + NGW < MTOK, lane);
    for (int s = gw; s < 96 + 64; s += NGW) {
        const bool isv = s >= 96; const int sl = isv ? s - 96 : s;
        const float* pe = p.in[isv ? I_PE_V : I_PE_K] + sl * 64; const float* w = p.in[isv ? I_W1_V : I_W1_K] + (size_t)sl * 64 * 256 + 4 * lane;
        f32x4 a = {0.f, 0.f, 0.f, 0.f};
        for (int k0 = 0; k0 < 64; k0 += 16) { f32x4 t[16]; float pv[16];
#pragma unroll
            for (int e = 0; e < 16; ++e) { t[e] = *(const f32x4*)(w + (size_t)(k0 + e) * 256); pv[e] = pe[k0 + e]; }
#pragma unroll
            for (int e = 0; e < 16; ++e) a += t[e] * pv[e]; }
        *(f32x4*)((float*)(ws + (isv ? WS_BPV : WS_BPK)) + sl * 256 + 4 * lane) = a;
    }
    for (int i = gw * 64 + lane; i < MTOK; i += NGW * 64) ((float*)(ws + WS_SUMSQ))[i] = 0.f;
    for (int i = gw * 64 + lane; i < 12 * MTOK; i += NGW * 64) ((float*)(ws + WS_SSQ))[i] = 0.f;
}

__device__ __forceinline__ float log_sigmoid(float z) { return fminf(z, 0.f) - log1pf(__expf(-fabsf(z))); }

__device__ __forceinline__ float log_sigmoid_fast(float z) { return fminf(z, 0.f) - __logf(1.f + __expf(-fabsf(z))); }
__device__ __forceinline__ void phase_cumsum(const Params& p, int gw, int NGW, int lane) {
    unsigned char* ws = p.ws;
    asm volatile("" : "+v"(lane));
    for (int task = gw; task < BATCH * FH; task += NGW) {
        const int b = task / FH, h = task - b * FH; const float bias = p.in[I_FOX_F_BIAS][h];
        const float* sm = (const float*)(ws + WS_SMALL) + ((size_t)b * SEQ + 32 * lane) * 32 + h;
        float v[32];
#pragma unroll
        for (int i = 0; i < 32; ++i) v[i] = sm[(size_t)i * 32];
        float run = 0.f;
#pragma unroll
        for (int i = 0; i < 32; ++i) { run += log_sigmoid_fast(v[i] + bias); v[i] = run; }
        float incl = run;
#pragma unroll
        for (int o = 1; o < 64; o <<= 1) { const float y = __shfl_up(incl, o); if (lane >= o) incl += y; }
        const float off = incl - run;
        f32x4* cf = (f32x4*)((float*)(ws + WS_CF) + ((size_t)b * FH + h) * SEQ + 32 * lane);
#pragma unroll
        for (int i = 0; i < 8; ++i) cf[i] = (f32x4){v[4 * i] + off, v[4 * i + 1] + off, v[4 * i + 2] + off, v[4 * i + 3] + off};
    }
}
__device__ __forceinline__ void phase_ffn_weights(const Params& p, LAS unsigned char* lds, int cw, int NCW, int wave, int lane, int first, int last  ) {
    unsigned char* ws = p.ws;
    LAS float* scr = (LAS float*)(lds + wave * 16384);
    constexpr int I_GU = 32 * (NGU / 32), I_D = (DFF / 64) * 64;
    auto desc = [&](int it) -> TrDesc {
        if (it < I_GU) return tr_desc<2>(p.in[I_W_GATE], p.in[I_W_UP], DFF, (bf16*)(ws + WS_WGU), 2048, 0, p.in[I_NORM_FFN], NGU / 32, it, lane);
        return tr_desc<0>(p.in[I_W_DOWN], nullptr, 2048, (bf16*)(ws + WS_WD), DFF, 0, nullptr, 64, it - I_GU, lane);
    };
    tr_pipeline3<true>(desc, first + cw, last, NCW, scr, lane);
}

constexpr int CONV_GU_SPLIT = 8192;

__device__ __forceinline__ void cmp_finish_unit(const Params& p, LAS unsigned char* lds, int u, int tid) {
    unsigned char* ws = p.ws;
    asm volatile("" : "+v"(tid));
    const bool isv = u >= 128; const int r0 = (u & 127) * 8;
    const int nsl = isv ? KS_V : KS_K, nbp = isv ? 64 : 96, ncol = isv ? 128 : 192;
    const float* slab = (const float*)(ws + (isv ? WS_HSLV : WS_HSLK)); const float* bp = (const float*)(ws + (isv ? WS_BPV : WS_BPK));
    const float* w2 = p.in[isv ? I_W2_V : I_W2_K];
    LAS float* hid = (LAS float*)lds;
    LAS float* bias = hid + 8 * 256;
    LAS float* ob = bias + 256;
    if (tid < 256) bias[tid] = ((const float*)(ws + WS_BIAS))[(isv ? 256 : 0) + tid];
    __syncthreads();
    for (int idx = tid; idx < 8 * 256; idx += NTHREADS) { const int r = idx >> 8, n = idx & 255; float s = bias[n]; float t[12];
#pragma unroll
        for (int k = 0; k < 12; ++k) t[k] = k < nsl ? slab[((size_t)k * CROWS + r0 + r) * 256 + n] : 0.f;
#pragma unroll
        for (int k = 0; k < 12; ++k) s += t[k];
        hid[idx] = s / (1.f + __expf(-s)); }
    __syncthreads();
    const int c = tid & 255, rg = tid >> 8;
    float a[4] = {0.f, 0.f, 0.f, 0.f};
    if (c < ncol) {
        float w[16], wn[16];
#pragma unroll
        for (int i = 0; i < 16; ++i) w[i] = w2[(size_t)i * ncol + c];
        for (int n0 = 0; n0 < 256; n0 += 16) {
            if (n0 + 16 < 256) {
#pragma unroll
                for (int i = 0; i < 16; ++i) wn[i] = w2[(size_t)(n0 + 16 + i) * ncol + c];
            }
#pragma unroll
            for (int i4 = 0; i4 < 4; ++i4)
#pragma unroll
                for (int r = 0; r < 4; ++r) { const f32x4 h = *(const LAS f32x4*)(hid + (rg * 4 + r) * 256 + n0 + 4 * i4);
                    a[r] += (h[0] * w[4 * i4] + h[1] * w[4 * i4 + 1]) + (h[2] * w[4 * i4 + 2] + h[3] * w[4 * i4 + 3]); }
#pragma unroll
            for (int i = 0; i < 16; ++i) w[i] = wn[i];
        }
        if (isv) {
#pragma unroll
            for (int r = 0; r < 4; ++r) ((bf16*)(ws + WS_VCC))[(size_t)(r0 + rg * 4 + r) * 128 + c] = (bf16)f2bf(a[r]);
        } else {
#pragma unroll
            for (int r = 0; r < 4; ++r) ob[(rg * 4 + r) * 192 + c] = a[r];
        }
    }
    __syncthreads();
    if (!isv) {
        const int w = tid >> 6, lane = tid & 63;
        const float v0 = ob[w * 192 + lane], v1 = ob[w * 192 + 64 + lane], v2 = ob[w * 192 + 128 + lane];
        const float r = 1.0f / sqrtf(wsum(v0 * v0 + v1 * v1 + v2 * v2) * (1.0f / 192.f) + EPS);
        const float* g = p.in[I_NSA_KC_GAIN]; bf16* o = (bf16*)(ws + WS_KCC) + (size_t)(r0 + w) * 192;
        o[lane] = (bf16)f2bf(v0 * r * g[lane]); o[64 + lane] = (bf16)f2bf(v1 * r * g[64 + lane]); o[128 + lane] = (bf16)f2bf(v2 * r * g[128 + lane]);
    }
    __syncthreads();
}


namespace att {
typedef short v4i16 __attribute__((ext_vector_type(4)));
typedef float f32x2_t __attribute__((ext_vector_type(2)));
typedef __bf16 bf16x2_t __attribute__((ext_vector_type(2)));
constexpr float LOG2E = 1.4426950408889634f;
constexpr int VP = 288;
constexpr int LDS_K0 = 0, LDS_K1 = 26624, LDS_V0 = 53248, LDS_V1 = 71680, LDS_IMP = 90112  , LDS_TOT = 122880  , LDS_SEL = 131072  ,
              LDS_AUX = 131584  , LDS_QW = 132608  , LDS_GATE = 133120  ;
__device__ __forceinline__ unsigned cvtpk(float lo, float hi) { f32x2_t v = {lo, hi}; bf16x2_t b = __builtin_convertvector(v, bf16x2_t); return __builtin_bit_cast(unsigned, b); }
__device__ __forceinline__ float x16(float v, float& o) { const auto r = __builtin_amdgcn_permlane16_swap(__float_as_uint(v), __float_as_uint(v), false, false); o = __uint_as_float(r[1]); return __uint_as_float(r[0]); }
__device__ __forceinline__ float x32(float v, float& o) { const auto r = __builtin_amdgcn_permlane32_swap(__float_as_uint(v), __float_as_uint(v), false, false); o = __uint_as_float(r[1]); return __uint_as_float(r[0]); }
__device__ __forceinline__ float gmax(float v) { float o; float a = x16(v, o); v = fmaxf(a, o); a = x32(v, o); return fmaxf(a, o); }
__device__ __forceinline__ float gsum(float v) { float o; float a = x16(v, o); v = a + o; a = x32(v, o); return a + o; }
template <int DKT> __device__ __forceinline__ int koff(int row, int ch) { return row * (DKT * 2 + 32) + (ch << 4); }
__device__ __forceinline__ int voff(int row, int ch) { return row * VP + (ch << 4); }

template <int DKT, int MODE> struct Stage {
    static constexpr int KCH = DKT / 8, NKP = DKT / 64;
    u32x4 k[NKP]; u32x4 v[2]; f32x4 aux;
    __device__ __forceinline__ void load(const bf16* Kg, int kpitch, const bf16* Vg, int vpitch, const float* cf, const float* rk, int j, int tid) {
        const int row = tid >> 3, c8 = tid & 7;
        const char* kt = (const char*)(Kg + (size_t)(64 * j) * kpitch); const unsigned ko = (unsigned)(row * kpitch + c8 * 8) * 2u;
        const char* vt = (const char*)(Vg + (size_t)(64 * j) * vpitch); const unsigned vo = (unsigned)(row * vpitch + c8 * 8) * 2u;
#pragma unroll
        for (int i = 0; i < NKP; ++i) k[i] = *(const u32x4*)(kt + ko + 128 * i);
#pragma unroll
        for (int i = 0; i < 2; ++i) v[i] = *(const u32x4*)(vt + vo + 128 * i);
        if (MODE != 1) { if (tid < 32) { const float* src = (MODE == 0 && tid < 16) ? cf : rk; aux = *(const f32x4*)(src + 64 * j + 4 * (tid & 15)); } }
    }
    __device__ __forceinline__ void store(LAS unsigned char* Kb, LAS unsigned char* Vb, LAS float* auxb, float cref, int tid) const {
        const int row = tid >> 3, c8 = tid & 7;
#pragma unroll
        for (int i = 0; i < NKP; ++i) *(LAS u32x4*)(Kb + koff<DKT>(row, c8 + 8 * i)) = k[i];
#pragma unroll
        for (int i = 0; i < 2; ++i) *(LAS u32x4*)(Vb + voff(row, c8 + 8 * i)) = v[i];
        if (MODE != 1) { if (tid < 32) { f32x4 o;
            if (MODE == 0 && tid < 16) o = (cref - aux) * LOG2E;
            else { const f32x4 sq = aux * (1.0f / DKT) + EPS; o = (f32x4){__builtin_amdgcn_rsqf(sq[0]), __builtin_amdgcn_rsqf(sq[1]), __builtin_amdgcn_rsqf(sq[2]), __builtin_amdgcn_rsqf(sq[3])}; }
            *(LAS f32x4*)(auxb + ((MODE == 0 && tid < 16) ? 0 : 64) + 4 * (tid & 15)) = o; } }
    }
};

struct Ctx {
    float sl;
    const float* cf;
    const float* rk;
    float cref;
    int q0;
    int tq0;
    unsigned selm[2];
};

template <int DKT, int MODE> __device__ __forceinline__ void qk_half(f32x4 (&S)[2][2], const LAS unsigned char* Kb, const LAS float* auxb, const bf16x8 (&Q)[2][DKT / 32], const Ctx& c, int j, int hf, bool need_mask, int lane) {
    const int i16 = lane & 15, g = lane >> 4;
    const int kbase = i16 * (DKT * 2 + 32) + g * 16;
#pragma unroll
    for (int k2 = 0; k2 < 2; ++k2) {
        if (MODE == 1) { const int kl0 = 64 * j + 16 * (2 * hf + k2) + 4 * g; const float b0 = c.sl * (float)(16 * kl0 + 31 - c.q0);
            const f32x4 bias = (f32x4){b0, b0 + 16.f * c.sl, b0 + 32.f * c.sl, b0 + 48.f * c.sl}; S[0][k2] = bias; S[1][k2] = bias; }
        else { S[0][k2] = (f32x4){0.f, 0.f, 0.f, 0.f}; S[1][k2] = (f32x4){0.f, 0.f, 0.f, 0.f}; }
    }
    {
        bf16x8 ka[2], kb[2];
#define ATT_LDK(dst, ks_) do { _Pragma("unroll") for (int k2 = 0; k2 < 2; ++k2) dst[k2] = *(const LAS bf16x8*)(Kb + kbase + ((2 * hf + k2) * 16 * (DKT * 2 + 32) + (ks_) * 64)); } while (0)
#define ATT_MMK(src, ks_) do { _Pragma("unroll") for (int k2 = 0; k2 < 2; ++k2) { \
        S[0][k2] = __builtin_amdgcn_mfma_f32_16x16x32_bf16(src[k2], Q[0][ks_], S[0][k2], 0, 0, 0); \
        S[1][k2] = __builtin_amdgcn_mfma_f32_16x16x32_bf16(src[k2], Q[1][ks_], S[1][k2], 0, 0, 0); } } while (0)
        ATT_LDK(ka, 0);
#pragma unroll
        for (int ks = 0; ks < DKT / 32; ks += 2) {
            ATT_LDK(kb, ks + 1);
            ATT_MMK(ka, ks);
            if (ks + 2 < DKT / 32) ATT_LDK(ka, ks + 2);
            ATT_MMK(kb, ks + 1);
        }
#undef ATT_LDK
#undef ATT_MMK
    }
    if (MODE != 1) {
#pragma unroll
        for (int k2 = 0; k2 < 2; ++k2) {
            const int kq = 16 * (2 * hf + k2) + 4 * g;
            const f32x4 rs = *(const LAS f32x4*)(auxb + 64 + kq);
            f32x4 bias;
            if (MODE == 0) bias = *(const LAS f32x4*)(auxb + kq);
            else { const float b0 = c.sl * (float)(64 * j + kq - c.q0); bias = (f32x4){b0, b0 + c.sl, b0 + 2.f * c.sl, b0 + 3.f * c.sl}; }
#pragma unroll
            for (int e = 0; e < 4; ++e) { float t0 = __builtin_fmaf(S[0][k2][e], rs[e], bias[e]), t1 = __builtin_fmaf(S[1][k2][e], rs[e], bias[e]);
                                          asm("" : "+v"(t0)); asm("" : "+v"(t1)); S[0][k2][e] = t0; S[1][k2][e] = t1; }
        }
    }
    if (need_mask) {
#pragma unroll
        for (int qg = 0; qg < 2; ++qg)
#pragma unroll
            for (int k2 = 0; k2 < 2; ++k2)
#pragma unroll
                for (int r = 0; r < 4; ++r) {
                    const int kl = 64 * j + 16 * (2 * hf + k2) + 4 * g + r; bool ok;
                    if (MODE == 0) ok = kl <= (c.tq0 + 16 * qg);
                    else if (MODE == 1) ok = 16 * kl + 31 <= (c.tq0 + 16 * qg);
                    else if (MODE == 2) ok = (kl <= (c.tq0 + 16 * qg)) && ((c.selm[qg] >> j) & 1u);
                    else ok = (kl <= (c.tq0 + 16 * qg)) && ((c.tq0 + 16 * qg) - kl < 512);
                    if (!ok) S[qg][k2][r] = -INFINITY;
                }
    }
}

__device__ __forceinline__ void softmax_pv_half(f32x4 (&S)[2][2], const LAS unsigned char* Vb, int hf, f32x4 (&O)[2][8], float (&m)[2], float (&l)[2], int lane) {
    const int i16 = lane & 15, g = lane >> 4;
    bf16x8 P[2];
#pragma unroll
    for (int qg = 0; qg < 2; ++qg) {
        float tm = fmaxf(fmaxf(fmaxf(S[qg][0][0], S[qg][0][1]), fmaxf(S[qg][0][2], S[qg][0][3])), fmaxf(fmaxf(S[qg][1][0], S[qg][1][1]), fmaxf(S[qg][1][2], S[qg][1][3])));
        tm = gmax(tm);
        const float mn = fmaxf(m[qg], tm), mr = (mn == -INFINITY) ? 0.f : mn;
        const float alpha = __builtin_amdgcn_exp2f(m[qg] - mr); m[qg] = mn;
        float ls = 0.f;
#pragma unroll
        for (int k2 = 0; k2 < 2; ++k2)
#pragma unroll
            for (int r = 0; r < 4; ++r) { const float pv = __builtin_amdgcn_exp2f(S[qg][k2][r] - mr); S[qg][k2][r] = pv; ls += pv; }
        l[qg] = l[qg] * alpha + ls;
        if (__any(alpha < 1.f)) {
#pragma unroll
            for (int db = 0; db < 8; ++db) O[qg][db] *= alpha;
        }
        u32x4 w; w.x = cvtpk(S[qg][0][0], S[qg][0][1]); w.y = cvtpk(S[qg][0][2], S[qg][0][3]); w.z = cvtpk(S[qg][1][0], S[qg][1][1]); w.w = cvtpk(S[qg][1][2], S[qg][1][3]);
        P[qg] = __builtin_bit_cast(bf16x8, w);
    }
    const int q4 = i16 >> 2, p4 = i16 & 3;
    const int vbase = (4 * g + q4) * VP + (p4 >> 1) * 16 + (p4 & 1) * 8;
    {
        v4i16 a0[2], b0[2], a1[2], b1[2];
#define ATT_LDV(A, B, gi) do { _Pragma("unroll") for (int e = 0; e < 2; ++e) { const int db = 2 * (gi) + e; \
        A[e] = __builtin_amdgcn_ds_read_tr16_b64_v4i16((LAS v4i16*)(Vb + vbase + (hf * 32 * VP + db * 32))); \
        B[e] = __builtin_amdgcn_ds_read_tr16_b64_v4i16((LAS v4i16*)(Vb + vbase + (hf * 32 * VP + 16 * VP + db * 32))); } } while (0)
#define ATT_MMV(A, B, gi) do { _Pragma("unroll") for (int e = 0; e < 2; ++e) { const int db = 2 * (gi) + e; \
        const bf16x8 vf = (bf16x8){A[e][0], A[e][1], A[e][2], A[e][3], B[e][0], B[e][1], B[e][2], B[e][3]}; \
        O[0][db] = __builtin_amdgcn_mfma_f32_16x16x32_bf16(vf, P[0], O[0][db], 0, 0, 0); \
        O[1][db] = __builtin_amdgcn_mfma_f32_16x16x32_bf16(vf, P[1], O[1][db], 0, 0, 0); } } while (0)
        ATT_LDV(a0, b0, 0);
        ATT_LDV(a1, b1, 1); ATT_MMV(a0, b0, 0);
        ATT_LDV(a0, b0, 2); ATT_MMV(a1, b1, 1);
        ATT_LDV(a1, b1, 3); ATT_MMV(a0, b0, 2);
        ATT_MMV(a1, b1, 3);
#undef ATT_LDV
#undef ATT_MMV
    }
}

__device__ __forceinline__ void softmax_pv_full(f32x4 (&S)[2][2], f32x4 (&S1)[2][2], const LAS unsigned char* Vb, f32x4 (&O)[2][8], float (&m)[2], float (&l)[2], int lane) {
    const int i16 = lane & 15, g = lane >> 4;
    bf16x8 P[2][2];
#pragma unroll
    for (int qg = 0; qg < 2; ++qg) {
        float tm = fmaxf(fmaxf(fmaxf(S[qg][0][0], S[qg][0][1]), fmaxf(S[qg][0][2], S[qg][0][3])), fmaxf(fmaxf(S[qg][1][0], S[qg][1][1]), fmaxf(S[qg][1][2], S[qg][1][3])));
        const float tm1 = fmaxf(fmaxf(fmaxf(S1[qg][0][0], S1[qg][0][1]), fmaxf(S1[qg][0][2], S1[qg][0][3])), fmaxf(fmaxf(S1[qg][1][0], S1[qg][1][1]), fmaxf(S1[qg][1][2], S1[qg][1][3])));
        tm = gmax(fmaxf(tm, tm1));
        const float mn = fmaxf(m[qg], tm), mr = (mn == -INFINITY) ? 0.f : mn;
        const float alpha = __builtin_amdgcn_exp2f(m[qg] - mr); m[qg] = mn;
        float ls = 0.f, ls1 = 0.f;
#pragma unroll
        for (int k2 = 0; k2 < 2; ++k2)
#pragma unroll
            for (int r = 0; r < 4; ++r) { const float pv = __builtin_amdgcn_exp2f(S[qg][k2][r] - mr); S[qg][k2][r] = pv; ls += pv;
                                          const float pw = __builtin_amdgcn_exp2f(S1[qg][k2][r] - mr); S1[qg][k2][r] = pw; ls1 += pw; }
        l[qg] = l[qg] * alpha + (ls + ls1);
        if (__any(alpha < 1.f)) {
#pragma unroll
            for (int db = 0; db < 8; ++db) O[qg][db] *= alpha;
        }
        u32x4 w; w.x = cvtpk(S[qg][0][0], S[qg][0][1]); w.y = cvtpk(S[qg][0][2], S[qg][0][3]); w.z = cvtpk(S[qg][1][0], S[qg][1][1]); w.w = cvtpk(S[qg][1][2], S[qg][1][3]);
        P[0][qg] = __builtin_bit_cast(bf16x8, w);
        w.x = cvtpk(S1[qg][0][0], S1[qg][0][1]); w.y = cvtpk(S1[qg][0][2], S1[qg][0][3]); w.z = cvtpk(S1[qg][1][0], S1[qg][1][1]); w.w = cvtpk(S1[qg][1][2], S1[qg][1][3]);
        P[1][qg] = __builtin_bit_cast(bf16x8, w);
    }
    const int q4 = i16 >> 2, p4 = i16 & 3;
    const int vbase = (4 * g + q4) * VP + (p4 >> 1) * 16 + (p4 & 1) * 8;
    {
        v4i16 a0[2], b0[2], a1[2], b1[2];
#define ATT_LDV(A, B, gi) do { _Pragma("unroll") for (int e = 0; e < 2; ++e) { const int db = 2 * ((gi) & 3) + e, hf = (gi) >> 2; \
        A[e] = __builtin_amdgcn_ds_read_tr16_b64_v4i16((LAS v4i16*)(Vb + vbase + (hf * 32 * VP + db * 32))); \
        B[e] = __builtin_amdgcn_ds_read_tr16_b64_v4i16((LAS v4i16*)(Vb + vbase + (hf * 32 * VP + 16 * VP + db * 32))); } } while (0)
#define ATT_MMV(A, B, gi) do { _Pragma("unroll") for (int e = 0; e < 2; ++e) { const int db = 2 * ((gi) & 3) + e, hf = (gi) >> 2; \
        const bf16x8 vf = (bf16x8){A[e][0], A[e][1], A[e][2], A[e][3], B[e][0], B[e][1], B[e][2], B[e][3]}; \
        O[0][db] = __builtin_amdgcn_mfma_f32_16x16x32_bf16(vf, P[hf][0], O[0][db], 0, 0, 0); \
        O[1][db] = __builtin_amdgcn_mfma_f32_16x16x32_bf16(vf, P[hf][1], O[1][db], 0, 0, 0); } } while (0)
        ATT_LDV(a0, b0, 0);
        ATT_LDV(a1, b1, 1); ATT_MMV(a0, b0, 0);
        ATT_LDV(a0, b0, 2); ATT_MMV(a1, b1, 1);
        ATT_LDV(a1, b1, 3); ATT_MMV(a0, b0, 2);
        ATT_LDV(a0, b0, 4); ATT_MMV(a1, b1, 3);
        ATT_LDV(a1, b1, 5); ATT_MMV(a0, b0, 4);
        ATT_LDV(a0, b0, 6); ATT_MMV(a1, b1, 5);
        ATT_LDV(a1, b1, 7); ATT_MMV(a0, b0, 6);
        ATT_MMV(a1, b1, 7);
#undef ATT_LDV
#undef ATT_MMV
    }
}

template <int DKT, int MODE> __device__ __forceinline__ void branch(LAS unsigned char* lds, unsigned tiles, unsigned mskb, unsigned skipb, const bf16* Kg, int kpitch, const bf16* Vg, int vpitch,
                                                                    const bf16x8 (&Q)[2][DKT / 32], f32x4 (&O)[2][8], float (&m)[2], float (&l)[2], const Ctx& c, int tid, int lane,
                                                                    Stage<DKT, MODE>& st, bool preloaded  ) {
    LAS float* AUX = (LAS float*)(lds + LDS_AUX);
    int j = 31 - __builtin_clz(tiles), ib = 0;
    asm volatile("" : "+v"(tid), "+v"(lane));
    if (!preloaded) st.load(Kg, kpitch, Vg, vpitch, c.cf, c.rk, j, tid);
    st.store(lds + LDS_K0, lds + LDS_V0, AUX, c.cref, tid);
    tiles &= ~(1u << j);
    int nj = tiles ? 31 - __builtin_clz(tiles) : -1;
    if (nj >= 0) st.load(Kg, kpitch, Vg, vpitch, c.cf, c.rk, nj, tid);
    __syncthreads();
    for (;;) {
        asm volatile("" : "+v"(tid), "+v"(lane));
        const LAS unsigned char* Kb = lds + (ib ? LDS_K1 : LDS_K0); const LAS unsigned char* Vb = lds + (ib ? LDS_V1 : LDS_V0); const LAS float* auxb = AUX + (ib ? 128 : 0);
        const bool skip = (skipb >> j) & 1u, nm = (mskb >> j) & 1u;
        f32x4 S[2][2], S1[2][2];
        if (!skip) {
            qk_half<DKT, MODE>(S, Kb, auxb, Q, c, j, 0, nm, lane); qk_half<DKT, MODE>(S1, Kb, auxb, Q, c, j, 1, nm, lane);
        }
        int nn = -1;
        if (nj >= 0) { st.store(lds + (ib ? LDS_K0 : LDS_K1), lds + (ib ? LDS_V0 : LDS_V1), AUX + (ib ? 0 : 128), c.cref, tid);
            tiles &= ~(1u << nj); nn = tiles ? 31 - __builtin_clz(tiles) : -1;
            if (nn >= 0) st.load(Kg, kpitch, Vg, vpitch, c.cf, c.rk, nn, tid); }
        if (!skip) softmax_pv_full(S, S1, Vb, O, m, l, lane);
        __syncthreads();
        if (nj < 0) break;
        ib ^= 1; j = nj; nj = nn;
    }
}

template <int DKT> __device__ __forceinline__ void load_q(bf16x8 (&Q)[2][DKT / 32], const bf16* qrow0  , size_t qg_stride, const float* gain, const float* gain2, float scale, int lane) {
    const int g = lane >> 4;
#pragma unroll
    for (int qg = 0; qg < 2; ++qg) {
        u32x4 raw[DKT / 32]; float ss = 0.f;
#pragma unroll
        for (int ks = 0; ks < DKT / 32; ++ks) { raw[ks] = *(const u32x4*)(qrow0 + qg * qg_stride + 32 * ks + 8 * g);
#pragma unroll
            for (int e = 0; e < 4; ++e) { const float a = __uint_as_float(raw[ks][e] << 16), b = __uint_as_float(raw[ks][e] & 0xffff0000u); ss += a * a + b * b; } }
        ss = gsum(ss);
        const float r = scale / sqrtf(ss * (1.0f / DKT) + EPS);
#pragma unroll
        for (int ks = 0; ks < DKT / 32; ++ks) asm volatile("" : "+v"(raw[ks]));
#pragma unroll
        for (int ks = 0; ks < DKT / 32; ++ks) { f32x4 g0 = *(const f32x4*)(gain + 32 * ks + 8 * g), g1 = *(const f32x4*)(gain + 32 * ks + 8 * g + 4); u32x4 w;
            if (gain2) { g0 *= *(const f32x4*)(gain2 + 32 * ks + 8 * g); g1 *= *(const f32x4*)(gain2 + 32 * ks + 8 * g + 4); }
#pragma unroll
            for (int e = 0; e < 4; ++e) { const float a = __uint_as_float(raw[ks][e] << 16), b = __uint_as_float(raw[ks][e] & 0xffff0000u);
                const float ga = e < 2 ? g0[2 * e] : g1[2 * e - 4], gb = e < 2 ? g0[2 * e + 1] : g1[2 * e - 3]; w[e] = cvtpk(a * r * ga, b * r * gb); }
            Q[qg][ks] = __builtin_bit_cast(bf16x8, w); }
    }
}

__device__ __forceinline__ void fox_unit(const Params& p, LAS unsigned char* lds, int b, int h, int qb, int tid, int wave, int lane, unsigned* qctr, volatile LAS unsigned* qslot) {
    unsigned char* ws = p.ws;
    asm volatile("" : "+v"(tid), "+v"(lane));
    const int i16 = lane & 15, g = lane >> 4, q0 = 256 * qb;
    const size_t rowb = (size_t)b * SEQ;
    bf16x8 Q[2][4];
    load_q<128>(Q, (const bf16*)(ws + WS_FQ) + (rowb + q0 + 32 * wave + i16) * 1024 + h * 128, (size_t)16 * 1024, p.in[I_FOX_Q_GAIN], p.in[I_FOX_K_GAIN], 0.08838834764831845f * LOG2E, lane);
    Ctx c; c.sl = 0.f; c.cf = (const float*)(ws + WS_CF) + ((size_t)b * FH + h) * SEQ; c.cref = c.cf[q0]; c.q0 = q0;
    c.rk = (const float*)(ws + WS_SSQ) + (size_t)h * MTOK + rowb;
    c.tq0 = q0 + 32 * wave + i16; c.selm[0] = 0u; c.selm[1] = 0u;
    f32x4 O[2][8]; float m[2] = {-INFINITY, -INFINITY}, l[2] = {0.f, 0.f};
#pragma unroll
    for (int qg = 0; qg < 2; ++qg)
#pragma unroll
        for (int db = 0; db < 8; ++db) O[qg][db] = (f32x4){0.f, 0.f, 0.f, 0.f};
    const unsigned nt = 4 * qb + 4, tiles = nt >= 32 ? 0xffffffffu : ((1u << nt) - 1u);
    const int qw = q0 + 32 * wave; const int jfull = (qw + 1) >> 6  , jvis = ((qw + 31) >> 6) + 1  ;
    const unsigned mskb = ~(jfull >= 32 ? 0xffffffffu : ((1u << jfull) - 1u)), skipb = jvis >= 32 ? 0u : ~((1u << jvis) - 1u);
    { Stage<128, 0> st0; branch<128, 0>(lds, tiles, mskb, skipb, (const bf16*)(ws + WS_FK) + rowb * 1024 + h * 128, 1024, (const bf16*)(ws + WS_FV) + rowb * 1024 + h * 128, 1024, Q, O, m, l, c, tid, lane, st0, false); }
    unsigned nxt = 0u;
    { int t0 = tid; asm volatile("" : "+v"(t0)); if (t0 == 0) nxt = gridDim.x + __hip_atomic_fetch_add(qctr, 1u, __ATOMIC_RELAXED, __HIP_MEMORY_SCOPE_AGENT); }
#pragma unroll
    for (int qg = 0; qg < 2; ++qg) {
        const float lt = gsum(l[qg]);
        const float inv = 1.0f / lt;
        bf16* orow = (bf16*)(ws + WS_OAB) + (rowb + (c.tq0 + 16 * qg)) * 2048 + h * 128 + 4 * g;
#pragma unroll
        for (int db = 0; db < 8; ++db) { const f32x4 o = O[qg][db] * inv; *(u32x2*)(orow + 16 * db) = (u32x2){cvtpk(o[0], o[1]), cvtpk(o[2], o[3])}; }
    }
    { int t0 = tid; asm volatile("" : "+v"(t0)); if (t0 == 0) qslot[0] = nxt; }
}

__device__ __forceinline__ float ulo(unsigned w) { return __uint_as_float(w << 16); }
__device__ __forceinline__ float uhi(unsigned w) { return __uint_as_float(w & 0xffff0000u); }

__device__ __forceinline__ void nsa_unit(const Params& p, LAS unsigned char* lds, int b, int gq, int cur, int tid, int wave, int lane, unsigned* qctr, volatile LAS unsigned* qslot) {
    unsigned char* ws = p.ws;
    asm volatile("" : "+v"(tid), "+v"(lane));
    const int i16 = lane & 15, g = lane >> 4, q0 = 64 * cur, hh = wave >> 1, h = gq * HPG + hh, rbase = 32 * (wave & 1);
    const size_t rowb = (size_t)b * SEQ;
    bf16x8 Q[2][6];
#define ATT_LOADQ(g2) do { int ln_ = lane; asm volatile("" : "+v"(ln_)); \
        load_q<192>(Q, (const bf16*)(ws + WS_NQ) + (rowb + q0 + rbase + (ln_ & 15)) * 1536 + h * 192, (size_t)16 * 1536, p.in[I_NSA_Q_GAIN], (g2), 0.07216878364870322f * LOG2E, ln_); } while (0)
    const bf16* KCC = (const bf16*)(ws + WS_KCC) + (size_t)((b * 2 + gq) * 128) * 192; const bf16* VCC = (const bf16*)(ws + WS_VCC) + (size_t)((b * 2 + gq) * 128) * 128;
    const unsigned ctiles = cur >= 16 ? 3u : 1u;
    Stage<192, 1> stc; stc.load(KCC, 192, VCC, 128, nullptr, nullptr, (ctiles & 2u) ? 1 : 0, tid);
    ATT_LOADQ(nullptr);
    Ctx c; c.sl = exp2f(-(float)(h + 1)) * LOG2E; c.cf = nullptr; c.rk = nullptr; c.cref = 0.f; c.q0 = q0;
    c.tq0 = q0 + rbase + i16; c.selm[0] = 0u; c.selm[1] = 0u;
    LAS float* IMP = (LAS float*)(lds + LDS_IMP); LAS float* TOT = (LAS float*)(lds + LDS_TOT); LAS unsigned* SEL = (LAS unsigned*)(lds + LDS_SEL);
    if (tid < 64) SEL[tid] = 0u;
    LAS float* GLG = (LAS float*)(lds + LDS_GATE) + wave * 128;
    { int ln_ = lane; asm volatile("" : "+v"(ln_));
      if (ln_ < 32) { const float* gp = (const float*)(ws + WS_SMALL) + (rowb + q0 + rbase + ln_) * 32 + 8 + h * 3; GLG[ln_ * 4 + 0] = gp[0]; GLG[ln_ * 4 + 1] = gp[1]; GLG[ln_ * 4 + 2] = gp[2]; } }
    f32x4 O[2][8]; float m[2], l[2];
#define ATT_RESET() do { _Pragma("unroll") for (int qg = 0; qg < 2; ++qg) { m[qg] = -INFINITY; l[qg] = 0.f; _Pragma("unroll") for (int db = 0; db < 8; ++db) O[qg][db] = (f32x4){0.f, 0.f, 0.f, 0.f}; } } while (0)
#define ATT_FOLD(br, first) do { int ln_ = lane; asm volatile("" : "+v"(ln_));        \
    _Pragma("unroll") for (int qg = 0; qg < 2; ++qg) { const float lt = gsum(l[qg]); \
        const size_t row_ = rowb + q0 + rbase + 16 * qg + (ln_ & 15); \
        const float gl_ = GLG[(16 * qg + (ln_ & 15)) * 4 + (br)]; \
        const float wgt = lt > 0.f ? 1.f / ((1.f + __expf(-gl_)) * lt) : 0.f; \
        bf16* orow = (bf16*)(ws + WS_OAB) + row_ * 2048 + 1024 + h * 128 + 4 * (ln_ >> 4); \
        _Pragma("unroll") for (int db = 0; db < 8; ++db) { f32x4 o = O[qg][db] * wgt; \
            if (!(first)) { const u32x2 pv = *(const u32x2*)(orow + 16 * db); o[0] += ulo(pv.x); o[1] += uhi(pv.x); o[2] += ulo(pv.y); o[3] += uhi(pv.y); } \
            *(u32x2*)(orow + 16 * db) = (u32x2){cvtpk(o[0], o[1]), cvtpk(o[2], o[3])}; } } } while (0)
    ATT_RESET();
    branch<192, 1>(lds, ctiles, 3u, 0u, KCC, 192, VCC, 128, Q, O, m, l, c, tid, lane, stc, true);
    ATT_FOLD(0, true);
    Stage<192, 2> sts;
    c.rk = (const float*)(ws + WS_SSQ) + (size_t)(8 + gq) * MTOK + rowb;
    sts.load((const bf16*)(ws + WS_KS) + rowb * 384 + gq * 192, 384, (const bf16*)(ws + WS_VS) + rowb * 256 + gq * 128, 256, nullptr, c.rk, cur, tid);
    {
        float invl[2], mr[2];
#pragma unroll
        for (int qg = 0; qg < 2; ++qg) { const float lt = gsum(l[qg]); invl[qg] = lt > 0.f ? 1.f / lt : 0.f; mr[qg] = (m[qg] == -INFINITY) ? 0.f : m[qg]; }
        float carry[2] = {0.f, 0.f};
        int ln2 = lane; asm volatile("" : "+v"(ln2));
        LAS float* improw = IMP + ((hh * 64) + rbase + (ln2 & 15)) * 32 + (ln2 >> 4);
#pragma unroll
        for (int tt = 0; tt < 2; ++tt)
#pragma unroll
            for (int hf = 0; hf < 2; ++hf) {
                f32x4 S[2][2];
                if (tt == 0 || (ctiles & 2u)) qk_half<192, 1>(S, lds + (((ctiles & 2u) ? (tt == 0) : false) ? LDS_K1 : LDS_K0), nullptr, Q, c, tt, hf, true, lane);
                else {
#pragma unroll
                    for (int qg = 0; qg < 2; ++qg)
#pragma unroll
                        for (int k2 = 0; k2 < 2; ++k2) S[qg][k2] = (f32x4){-INFINITY, -INFINITY, -INFINITY, -INFINITY};
                }
#pragma unroll
                for (int qg = 0; qg < 2; ++qg) {
                    float xprev = carry[qg];
#pragma unroll
                    for (int k2 = 0; k2 < 2; ++k2) {
                        float pr[4];
#pragma unroll
                        for (int r = 0; r < 4; ++r) pr[r] = __builtin_amdgcn_exp2f(S[qg][k2][r] - mr[qg]) * invl[qg];
                        const float up = __shfl(pr[3], (lane + 48) & 63);
                        const float wrap = __shfl(xprev, (lane + 48) & 63);
                        const float prev = g == 0 ? wrap : up;
                        improw[16 * qg * 32 + 16 * tt + 4 * (2 * hf + k2)] = 2.f * (pr[0] + pr[1] + pr[2]) + pr[3] + prev;
                        xprev = pr[3];
                    }
                    carry[qg] = xprev;
                }
            }
    }
    __syncthreads();
    {
        int tid2 = tid; asm volatile("" : "+v"(tid2));
        const int t = tid2 >> 3, jq = tid2 & 7;
#pragma unroll
        for (int e = 0; e < 4; ++e) { const int j = 4 * jq + e;
            const float im = (IMP[(0 * 64 + t) * 32 + j] + IMP[(1 * 64 + t) * 32 + j]) + (IMP[(2 * 64 + t) * 32 + j] + IMP[(3 * 64 + t) * 32 + j]);
            const bool elig = j <= cur, forced = (j == 0) || (elig && (cur - j) < 2);
            TOT[t * 32 + j] = elig ? (forced ? 1.0e4f : im) : -1.f; }
        __syncthreads();
        unsigned bits = 0u;
#pragma unroll
        for (int e = 0; e < 4; ++e) { const int j = 4 * jq + e; const float sj = TOT[t * 32 + j]; int rank = 0;
#pragma unroll 4
            for (int j2 = 0; j2 < 32; ++j2) { const float s2 = TOT[t * 32 + j2]; rank += (s2 > sj || (s2 == sj && j2 < j)) ? 1 : 0; }
            if (rank < 16 && sj >= 0.f) bits |= 1u << j; }
        if (bits) atomicOr((unsigned*)(SEL + t), bits);
        __syncthreads();
    }
    c.selm[0] = SEL[rbase + i16]; c.selm[1] = SEL[rbase + 16 + i16];
    unsigned U = SEL[lane];
#pragma unroll
    for (int o = 32; o > 0; o >>= 1) U |= __shfl_xor(U, o);
    U = __builtin_amdgcn_readfirstlane(U);
    ATT_RESET();
    { unsigned wand = c.selm[0] & c.selm[1], wor = c.selm[0] | c.selm[1];
#pragma unroll
      for (int o = 1; o < 16; o <<= 1) { wand &= __shfl_xor(wand, o); wor |= __shfl_xor(wor, o); }
      wand = __builtin_amdgcn_readfirstlane(wand); wor = __builtin_amdgcn_readfirstlane(wor);
      branch<192, 2>(lds, U, ~wand | (1u << cur), ~wor, (const bf16*)(ws + WS_KS) + rowb * 384 + gq * 192, 384, (const bf16*)(ws + WS_VS) + rowb * 256 + gq * 128, 256, Q, O, m, l, c, tid, lane, sts, true); }
    Stage<192, 3> stw;
    c.rk = (const float*)(ws + WS_SSQ) + (size_t)(10 + gq) * MTOK + rowb;
    stw.load((const bf16*)(ws + WS_KW) + rowb * 384 + gq * 192, 384, (const bf16*)(ws + WS_VW) + rowb * 256 + gq * 128, 256, nullptr, c.rk, cur, tid);
    ATT_FOLD(1, false);
    ATT_RESET();
    { const int jlo = cur >= 8 ? cur - 8 : 0; const unsigned hi_m = cur >= 31 ? 0xffffffffu : ((1u << (cur + 1)) - 1u); const unsigned wt = hi_m & ~((1u << jlo) - 1u);
      branch<192, 3>(lds, wt, (1u << cur) | (cur >= 8 ? (1u << (cur - 8)) : 0u), 0u, (const bf16*)(ws + WS_KW) + rowb * 384 + gq * 192, 384, (const bf16*)(ws + WS_VW) + rowb * 256 + gq * 128, 256, Q, O, m, l, c, tid, lane, stw, true); }
    unsigned nxt = 0u;
    { int t0 = tid; asm volatile("" : "+v"(t0)); if (t0 == 0) nxt = gridDim.x + __hip_atomic_fetch_add(qctr, 1u, __ATOMIC_RELAXED, __HIP_MEMORY_SCOPE_AGENT); }
    ATT_FOLD(2, false);
    { int t0 = tid; asm volatile("" : "+v"(t0)); if (t0 == 0) qslot[0] = nxt; }
#undef ATT_RESET
#undef ATT_FOLD
#undef ATT_LOADQ
    __syncthreads();
}

__device__ const unsigned short ATT_ORDER[576] = {276,277,278,279,280,281,282,283,284,285,286,287,308,309,310,311,312,313,314,315,316,317,318,319,340,341,342,343,344,345,346,347,348,349,350,351,372,373,374,375,376,377,378,379,380,381,382,383,404,405,406,407,408,409,410,411,412,413,414,415,436,437,438,439,440,441,442,443,444,445,446,447,468,469,470,471,472,473,474,475,476,477,478,479,500,501,502,503,504,505,506,507,508,509,510,511,275,307,339,371,403,435,467,499,274,306,338,370,402,434,466,498,273,305,337,369,401,433,465,497,272,304,336,368,400,432,464,496,271,303,335,367,399,431,463,495,270,302,334,366,398,430,462,494,269,301,333,365,397,429,461,493,268,300,332,364,396,428,460,492,267,299,331,363,395,427,459,491,266,298,330,362,394,426,458,490,265,297,329,361,393,425,457,489,264,296,328,360,392,424,456,488,263,295,327,359,391,423,455,487,262,294,326,358,390,422,454,486,7,15,23,31,39,47,55,63,71,79,87,95,103,111,119,127,135,143,151,159,167,175,183,191,199,207,215,223,231,239,247,255,261,293,325,357,389,421,453,485,6,14,22,30,38,46,54,62,70,78,86,94,102,110,118,126,134,142,150,158,166,174,182,190,198,206,214,222,230,238,246,254,260,292,324,356,388,420,452,484,259,291,323,355,387,419,451,483,5,13,21,29,37,45,53,61,69,77,85,93,101,109,117,125,133,141,149,157,165,173,181,189,197,205,213,221,229,237,245,253,258,290,322,354,386,418,450,482,4,12,20,28,36,44,52,60,68,76,84,92,100,108,116,124,132,140,148,156,164,172,180,188,196,204,212,220,228,236,244,252,257,289,321,353,385,417,449,481,256,288,320,352,384,416,448,480,3,11,19,27,35,43,51,59,67,75,83,91,99,107,115,123,131,139,147,155,163,171,179,187,195,203,211,219,227,235,243,251,512,513,514,515,516,517,518,519,520,521,522,523,524,525,526,527,528,529,530,531,532,533,534,535,536,537,538,539,540,541,542,543,544,545,546,547,548,549,550,551,552,553,554,555,556,557,558,559,560,561,562,563,564,565,566,567,568,569,570,571,572,573,574,575,2,10,18,26,34,42,50,58,66,74,82,90,98,106,114,122,130,138,146,154,162,170,178,186,194,202,210,218,226,234,242,250,1,9,17,25,33,41,49,57,65,73,81,89,97,105,113,121,129,137,145,153,161,169,177,185,193,201,209,217,225,233,241,249,0,8,16,24,32,40,48,56,64,72,80,88,96,104,112,120,128,136,144,152,160,168,176,184,192,200,208,216,224,232,240,248};

__device__ __forceinline__ void attn_phase(const Params& p, LAS unsigned char* lds, int vcu, int G, int tid, int wave, int lane) {
    unsigned* qctr = (unsigned*)(p.ws + WS_CTL) + 64;
    volatile LAS unsigned* qw = (volatile LAS unsigned*)(lds + LDS_QW);
    bool have = true;
    if (tid == 0) qw[0] = (unsigned)vcu;
    for (;;) {
        if (!have && tid == 0) qw[0] = (unsigned)G + __hip_atomic_fetch_add(qctr, 1u, __ATOMIC_RELAXED, __HIP_MEMORY_SCOPE_AGENT);
        __syncthreads();
        const unsigned slot = __builtin_amdgcn_readfirstlane(qw[0]);
        __syncthreads();
        if (slot >= 576u) break;
        const int id = ATT_ORDER[slot];
        have = id < 512;
        if (id < 256) fox_unit(p, lds, id >> 6, (id >> 3) & 7, id & 7, tid, wave, lane, qctr, qw);
        else if (id < 512) { const int v = id - 256; nsa_unit(p, lds, v >> 6, (v >> 5) & 1, v & 31, tid, wave, lane, qctr, qw); }
        else {
            pg8::Gemm g{(const bf16*)(p.ws + WS_XN), (const bf16*)(p.ws + WS_WIN), 2048, 2048, 2048};
            pg8::Gemm1Order S; S.so.init(MTOK, 10240, G, 0); S.tail = 1; S.tc = id - 512; S.Gt = 64;
            EpiProj E{p.ws, p.in[I_NSA_KS_GAIN], p.in[I_NSA_KW_GAIN]};
            pg8::gemm_phase<EpiProj, pg8::Gemm1Order, true>(lds, g, S, E, wave);
            __syncthreads();
        }
    }
}
}

__global__ void __launch_bounds__(NTHREADS, 2) fwd(Params p) {
    extern __shared__ __attribute__((aligned(16))) unsigned char lds_raw[];
    LAS unsigned char* lds = (LAS unsigned char*)lds_raw;
    const int wave = __builtin_amdgcn_readfirstlane((int)threadIdx.x >> 6);
#define TID_ (wave * 64 + lane_id())
#define LANE_ (lane_id())
    const int G = gridDim.x, bx = blockIdx.x;
    const int vcu = (G % 8 == 0) ? (bx % 8) * (G / 8) + bx / 8 : bx;
    const int gw = vcu * NWAVES + wave, NGW = G * NWAVES;
    unsigned char* ws = p.ws;
    const int lo = p.ph_lo, hi = p.ph_hi;
#ifndef ONLY_PHASE
#define ONLY_PHASE -1
#endif
#define IN(k) ((ONLY_PHASE < 0 || ONLY_PHASE == (k)) && lo <= (k) && (k) < hi)
    cg::grid_group grid = cg::this_grid();
    volatile LAS unsigned* bst = (volatile LAS unsigned*)(lds + LDS_BYTES - 16);
    if (TID_ < 4) bst[TID_] = 0u;
    __syncthreads();
    XcdBarrier xbar = xcd_barrier_post((unsigned*)(ws + WS_CTL) + 4096, bst, wave);
    if (p.ph_lo < 0) grid.sync();
#define SEAM(k) do { if (IN(k) && IN((k) + 1)) xcd_barrier(xbar); } while (0)
    if (IN(PH_P0)) { phase_p0(p, lds, gw, NGW, wave, LANE_); }
    SEAM(PH_P0);
    if (IN(PH_GEMM1)) {
        pg8::Gemm g{(const bf16*)(ws + WS_XN), (const bf16*)(ws + WS_WIN), 2048, 2048, 2048};
        pg8::Gemm1Order S; S.so.init(MTOK, 10240, G, bx); S.tail = 0; S.tc = 0; S.Gt = 1;
        EpiProj E{ws, p.in[I_NSA_KS_GAIN], p.in[I_NSA_KW_GAIN]};
        pg8::gemm_phase<EpiProj, pg8::Gemm1Order, true>(lds, g, S, E, wave);
    }
    SEAM(PH_GEMM1);
    if (IN(PH_P2A)) {
        if (bx == 200) {
            const int t_ = TID_; const bool isv = t_ >= 256; const int n = t_ & 255, nbp = isv ? 64 : 96;
            const float* bp = (const float*)(ws + (isv ? WS_BPV : WS_BPK)); float s0 = 0.f, s1 = 0.f, s2 = 0.f, s3 = 0.f;
            for (int i = 0; i < nbp; i += 16) { float t[16];
#pragma unroll
                for (int e = 0; e < 16; ++e) t[e] = bp[(i + e) * 256 + n];
#pragma unroll
                for (int e = 0; e < 16; e += 4) { s0 += t[e]; s1 += t[e + 1]; s2 += t[e + 2]; s3 += t[e + 3]; } }
            ((float*)(ws + WS_BIAS))[(isv ? 256 : 0) + n] = (s0 + s1) + (s2 + s3);
        }
        phase_cumsum(p, (G - 1 - vcu) * NWAVES + wave, NGW, LANE_);
        if (G == 256) {
            if ((bx >= 48 && bx < 128) || bx >= 160) { const int ci = (bx < 128 ? bx - 48 : bx - 80) * NWAVES + wave;
                phase_mix_weights(p, lds, ci, 176 * NWAVES, wave, LANE_); phase_ffn_weights(p, lds, ci, 176 * NWAVES, wave, LANE_, 0, CONV_GU_SPLIT); }
            else if (bx < 48 || bx >= 128) phase_ffn_weights(p, lds, (bx < 48 ? bx : bx - 80) * NWAVES + wave, 80 * NWAVES, wave, LANE_, CONV_GU_SPLIT, 11264);
        } else { phase_mix_weights(p, lds, gw, NGW, wave, LANE_); phase_ffn_weights(p, lds, gw, NGW, wave, LANE_, 0, 11264 + 5632); }

        __syncthreads();
        { pg8::Gemm g{(const bf16*)(ws + WS_KC), (const bf16*)(ws + WS_CW1K), 3072, 6144, KSLICE}; pg8::SplitOrder S{4, KS_K, G, bx};
          EpiSlab E{(float*)(ws + WS_HSLK)}; pg8::gemm_phase<EpiSlab, pg8::SplitOrder, false>(lds, g, S, E, wave); }
        { pg8::Gemm g{(const bf16*)(ws + WS_VC), (const bf16*)(ws + WS_CW1V), 2048, 4096, KSLICE}; pg8::SplitOrder S{4, KS_V, G, (bx + G / 2) % G};
          EpiSlab E{(float*)(ws + WS_HSLV)}; pg8::gemm_phase<EpiSlab, pg8::SplitOrder, false>(lds, g, S, E, wave); }

    }
    SEAM(PH_P2A);
    if (IN(PH_P2B)) {
        for (int u = bx; u < 256; u += G) cmp_finish_unit(p, lds, u, TID_);
    }
    SEAM(PH_P2B);
    if (IN(PH_ATTN)) { __syncthreads(); att::attn_phase(p, lds, vcu, G, TID_, wave, LANE_); }
    SEAM(PH_ATTN);
    if (IN(PH_MERGE)) {
        pg8::Gemm g{(const bf16*)(ws + WS_OAB), (const bf16*)(ws + WS_WU), 2048, 2048, 2048};
        pg8::StaticOrder S; S.init(MTOK, 2048, G, bx);
        EpiMerge E{(const bf16*)(ws + WS_GA), (const bf16*)(ws + WS_GB), (bf16*)(ws + WS_MERGED)};
        pg8::gemm_phase<EpiMerge, pg8::StaticOrder, false>(lds, g, S, E, wave);
    }
    SEAM(PH_MERGE);
    if (IN(PH_OUT)) {
        pg8::Gemm g{(const bf16*)(ws + WS_MERGED), (const bf16*)(ws + WS_WOUT), 2048, 2048, 2048};
        pg8::StaticOrder S; S.init(MTOK, 2048, G, bx);
        EpiOut E{p.in[I_X], p.out, (bf16*)(ws + WS_HB), (float*)(ws + WS_SUMSQ)};
        pg8::gemm_phase<EpiOut, pg8::StaticOrder, false>(lds, g, S, E, wave);
    }
    SEAM(PH_OUT);
    if (IN(PH_FFN)) {
        pg8::Gemm g{(const bf16*)(ws + WS_HB), (const bf16*)(ws + WS_WGU), 2048, 2048, 2048};
        pg8::StaticOrder S; S.init(MTOK, NGU, G, bx);
        EpiFfn E{(const float*)(ws + WS_SUMSQ), (bf16*)(ws + WS_ACT)};
        pg8::gemm_phase<EpiFfn, pg8::StaticOrder, true>(lds, g, S, E, wave);
        if (G == 256 && bx >= 128) phase_ffn_weights(p, lds, (bx - 128) * NWAVES + wave, 128 * NWAVES, wave, LANE_, 11264, 11264 + 5632);
    }
    SEAM(PH_FFN);
    if (IN(PH_DOWN)) {
        pg8::Gemm g{(const bf16*)(ws + WS_ACT), (const bf16*)(ws + WS_WD), DFF, DFF, DFF};
        pg8::StaticOrder S; S.init(MTOK, 2048, G, bx);
        EpiDown E{p.out, (const bf16*)(ws + WS_HB)};
        pg8::gemm_phase<EpiDown, pg8::StaticOrder, false>(lds, g, S, E, wave);
    }
#undef IN
#undef SEAM
#undef TID_
#undef LANE_
}

extern "C" void kernel_launch(void* const* d_in, const int* in_sizes, int n_in, void* d_out, int out_size, void* d_ws, size_t ws_size, hipStream_t stream) {
    static int grid = 0;
    if (grid == 0) {
        if (n_in != 23 || out_size != MTOK * DM || ws_size < WS_END) { fprintf(stderr, "kernel_launch: unexpected shapes / workspace (%d inputs, out %d, ws %zu < %zu)\n", n_in, out_size, ws_size, (size_t)WS_END); grid = -1; return; }
        int dev = 0, cus = 0;
        if (hipGetDevice(&dev) != hipSuccess || hipDeviceGetAttribute(&cus, hipDeviceAttributeMultiprocessorCount, dev) != hipSuccess) { grid = -1; return; }
        if (hipFuncSetAttribute((const void*)fwd, hipFuncAttributeMaxDynamicSharedMemorySize, LDS_BYTES) != hipSuccess) { fprintf(stderr, "kernel_launch: hipFuncSetAttribute failed\n"); grid = -1; return; }
        int per_cu = 0;
        if (hipOccupancyMaxActiveBlocksPerMultiprocessor(&per_cu, (const void*)fwd, NTHREADS, LDS_BYTES) != hipSuccess || per_cu < 1) { fprintf(stderr, "kernel_launch: occupancy query says %d blocks/CU\n", per_cu); grid = -1; return; }
        grid = cus;
    }
    if (grid < 0) return;
    (void)hipMemsetAsync((char*)d_ws + WS_CTL, 0, 32 * 1024, stream);
    Params p{};
    for (int i = 0; i < 23; ++i) p.in[i] = (const float*)d_in[i];
    p.out = (float*)d_out; p.ws = (unsigned char*)d_ws;
    p.ph_lo = 0; p.ph_hi = PH_N;
    void* args[] = {&p};
    hipError_t e = hipLaunchCooperativeKernel((const void*)fwd, dim3(grid), dim3(NTHREADS), args, LDS_BYTES, stream);
    if (e != hipSuccess) fprintf(stderr, "cooperative launch failed: %s (grid %d)\n", hipGetErrorString(e), grid);
}
```

```cpp
#include <hip/hip_runtime.h>
#include <hip/hip_cooperative_groups.h>
#include <cstdio>
#include <cstdint>
#include <cmath>

#define LAS __attribute__((address_space(3)))
typedef unsigned short bf16;
typedef short bf16x8 __attribute__((ext_vector_type(8)));
typedef float f32x4 __attribute__((ext_vector_type(4)));
typedef unsigned u32x4 __attribute__((ext_vector_type(4)));
typedef unsigned u32x2 __attribute__((ext_vector_type(2)));

constexpr int BATCH = 4, SEQ = 2048, DM = 2048, MTOK = BATCH * SEQ;
constexpr int FH = 8, FD = 128;
constexpr int NHD = 8, NG = 2, HPG = 4, DK = 192, DV = 128;
constexpr int DFF = 5632, DIN = 10656, DINP = 10752, NGU = 2 * DFF;
constexpr int CROWS = 1024;
constexpr float EPS = 1e-6f;
constexpr int KS_K = 12, KS_V = 8, KSLICE = 512;

constexpr size_t MiB = 1u << 20;
constexpr size_t WS_CTL = 0;
constexpr size_t WS_SMALL = 1 * MiB;
constexpr size_t WS_CF = 2 * MiB;
constexpr size_t WS_KCC = WS_CF + 256 * 1024;
constexpr size_t WS_VCC = WS_KCC + 384 * 1024;
constexpr size_t WS_SUMSQ = WS_VCC + 256 * 1024;
constexpr size_t WS_BPK = WS_SUMSQ + 32 * 1024;
constexpr size_t WS_BPV = WS_BPK + 96 * 1024;
constexpr size_t WS_BIAS = WS_BPV + 64 * 1024;
constexpr size_t WS_THR = WS_BIAS + 4096;
constexpr size_t WS_SSQ = 3 * MiB + 256 * 1024;
constexpr size_t WS_WU = 4 * MiB;
constexpr size_t WS_WOUT = 12 * MiB;
constexpr size_t WS_CW1K = 20 * MiB;
constexpr size_t WS_CW1V = 23 * MiB;
constexpr size_t WS_WGU = 25 * MiB;
constexpr size_t WS_WD = 69 * MiB;
constexpr size_t WS_WIN = 51 * MiB;
constexpr size_t WS_XN = 93 * MiB;
constexpr size_t WS_FQ = 125 * MiB, WS_FK = 141 * MiB, WS_FV = 157 * MiB;
constexpr size_t WS_NQ = 173 * MiB;
constexpr size_t WS_KC = 197 * MiB;
constexpr size_t WS_KS = 204 * MiB, WS_KW = 210 * MiB;
constexpr size_t WS_VC = 216 * MiB;
constexpr size_t WS_VS = 221 * MiB, WS_VW = 225 * MiB;
constexpr size_t WS_MERGED = 125 * MiB;
constexpr size_t WS_ACT = 125 * MiB;
constexpr size_t WS_GA = 229 * MiB, WS_GB = 261 * MiB;
constexpr size_t WS_HB = 229 * MiB;
constexpr size_t WS_OAB = 293 * MiB;
constexpr size_t WS_HSLK = 293 * MiB;
constexpr size_t WS_HSLV = 305 * MiB;
constexpr size_t WS_END = 325 * MiB;

static_assert(WS_WIN + (size_t)10240 * 4096 == WS_WD + (size_t)2048 * 5632 * 2 && WS_WGU + (size_t)11264 * 4096 == WS_WD, "FFN weight area ends where the surviving w_in rows begin");
__device__ __forceinline__ float bf2f(bf16 u) { return __uint_as_float((unsigned)u << 16); }
__device__ __forceinline__ unsigned f2bf(float f) { unsigned u = __float_as_uint(f); return (u + 0x7fffu + ((u >> 16) & 1u)) >> 16; }
__device__ __forceinline__ unsigned pk2(float lo, float hi) { return f2bf(lo) | (f2bf(hi) << 16); }
__device__ __forceinline__ float wsum(float v) {
#pragma unroll
    for (int o = 32; o > 0; o >>= 1) v += __shfl_xor(v, o);
    return v;
}
__device__ __forceinline__ float wmaxf(float v) {
#pragma unroll
    for (int o = 32; o > 0; o >>= 1) v = fmaxf(v, __shfl_xor(v, o));
    return v;
}
#define LDS_WAIT() asm volatile("s_waitcnt lgkmcnt(0)" ::: "memory")
__device__ __forceinline__ int lane_id() { int l; asm volatile("v_mbcnt_lo_u32_b32 %0, -1, 0\n\tv_mbcnt_hi_u32_b32 %0, -1, %0" : "=v"(l)); return l; }

namespace cg = cooperative_groups;
namespace pg8 {
constexpr int BM = 256, BK = 64, HALF = 128, HTB = HALF * BK * 2, STAGE_BYTES = 8 * HTB, NXCD = 8, WGM = 8;
__host__ __device__ __forceinline__ int lds_byte(int r, int c) { const int st = (r >> 4) * 2 + (c >> 5), rr = r & 15, cc = c & 31, ob = rr * 64 + cc * 2; return st * 1024 + (ob ^ (((ob >> 9) & 1) << 5)); }
__host__ __device__ __forceinline__ void stage_rc(int b, int& R, int& C) { const int st = b / 1024, sb = b % 1024, swz = sb ^ (((sb >> 9) & 1) << 5); R = (st >> 1) * 16 + swz / 64; C = (st & 1) * 32 + (swz % 64) / 2; }
__host__ __device__ __forceinline__ int perm32(int rho) { const int n = rho >> 4, i = rho & 15; return 8 * (i >> 2) + 4 * n + (i & 3); }

struct Unit { int pm, pn, ks; };
struct Gemm { const bf16* A; const bf16* Bt; int lda, ldb, K; };

struct StaticOrder {
    int nM, nN, nwg, G, c;
    __host__ __device__ void init(int M, int N, int G_, int c_) { nM = M / BM; nN = N / BM; nwg = nM * nN; G = G_; c = c_; }
    __host__ __device__ bool next(int i, Unit& u) const {
        const long L = (long)i * G + c; if (L >= nwg) return false;
        int wgid = (int)L; { const int q = nwg / NXCD, r = nwg % NXCD, xcd = wgid % NXCD, off = wgid / NXCD; wgid = (xcd < r ? xcd * (q + 1) : r * (q + 1) + (xcd - r) * q) + off; }
        const int nig = WGM * nN, gid = wgid / nig, fm = gid * WGM, gsz = (nM - fm) < WGM ? (nM - fm) : WGM;
        u.pm = fm + ((wgid % nig) % gsz); u.pn = (wgid % nig) / gsz; u.ks = 0; return true;
    }
    __device__ __forceinline__ void done(int) const {}
};
struct SplitOrder {
    int nM, nKS, G, c;
    __host__ __device__ bool next(int i, Unit& u) const { const long L = (long)i * G + c; if (L >= (long)nM * nKS) return false; u.pm = (int)(L % nM); u.pn = 0; u.ks = (int)(L / nM); return true; }
    __device__ __forceinline__ void done(int) const {}
};
struct Gemm1Order {
    StaticOrder so; int tail, tc, Gt;
    __device__ bool next(int i, Unit& u) const {
        if (!tail) return so.next(i, u);
        const long L = (long)i * Gt + tc; if (L >= 64) return false;
        u.pm = (int)(L >> 1); u.pn = 40 + (int)(L & 1); u.ks = 0; return true;
    }
    __device__ __forceinline__ void done(int) const {}
};

template <class Epi, class Sched, bool ALIGN_EPI>
__device__ __forceinline__ void gemm_phase(LAS unsigned char* lds, const Gemm g, const Sched& S, const Epi& E, int wid) {
    int lane_ = lane_id(); asm volatile("" : "+v"(lane_));
    const int lane = lane_, tid = wid * 64 + lane, wr = wid >> 2, wc = wid & 3, fr = lane & 15, fq = lane >> 4;
    const int K = g.K, nt = K / BK;
    unsigned voffA[2], voffB[2];
#pragma unroll
    for (int i = 0; i < 2; ++i) { int R, C; stage_rc(tid * 16 + i * 8192, R, C); const int Rb = Epi::PERM ? ((R & ~31) + perm32(R & 31)) : R;
        voffA[i] = (unsigned)(R * g.lda + C) * 2u; voffB[i] = (unsigned)(Rb * g.ldb + C) * 2u; }
    const size_t kstep = (size_t)(BK * 2);
    const size_t hA = (size_t)HALF * g.lda * 2, hB = (size_t)HALF * g.ldb * 2;
    const unsigned ldsw = (unsigned)wid * 1024u;
    const int aoff = lds_byte(wr * 64 + fr, fq * 8), boff = lds_byte(wc * 32 + fr, fq * 8);
#define PG8_SA(b, h) (((b) * 2 + (h)) * HTB)
#define PG8_SB(b, h) ((4 + (b) * 2 + (h)) * HTB)
#define PG8_STAGE(bufoff, gbase, voff) do { _Pragma("unroll") for (int _i = 0; _i < 2; ++_i) \
        __builtin_amdgcn_global_load_lds((const unsigned*)((const char*)(gbase) + (voff)[_i]), (LAS unsigned*)(lds + (bufoff) + ldsw + _i * 8192), 16, 0, 0); } while (0)
#define PG8_LDA(dst, b, h) do { _Pragma("unroll") for (int m = 0; m < 4; ++m) _Pragma("unroll") for (int k = 0; k < 2; ++k) dst[m][k] = *(const LAS bf16x8*)(lds + PG8_SA(b, h) + aoff + m * 2048 + k * 1024); } while (0)
#define PG8_LDB(dst, b, h) do { _Pragma("unroll") for (int n = 0; n < 2; ++n) _Pragma("unroll") for (int k = 0; k < 2; ++k) dst[n][k] = *(const LAS bf16x8*)(lds + PG8_SB(b, h) + boff + n * 2048 + k * 1024); } while (0)
#define PG8_MMA(ai, bj, At, Bt) do { __builtin_amdgcn_s_setprio(1); _Pragma("unroll") for (int m = 0; m < 4; ++m) _Pragma("unroll") for (int n = 0; n < 2; ++n) _Pragma("unroll") for (int k = 0; k < 2; ++k) \
        acc[ai][bj][m][n] = __builtin_amdgcn_mfma_f32_16x16x32_bf16(Bt[n][k], At[m][k], acc[ai][bj][m][n], 0, 0, 0); __builtin_amdgcn_s_setprio(0); } while (0)
#define PG8_WAIT_V(n) asm volatile("s_waitcnt vmcnt(" #n ")" ::: "memory")
#define PG8_WAIT_L(n) asm volatile("s_waitcnt lgkmcnt(" #n ")" ::: "memory")
#define PG8_BAR __builtin_amdgcn_s_barrier()
#define PG8_SCHED __builtin_amdgcn_sched_barrier(0)
    Unit cur, nxt; int ui = 0;
    if (!S.next(0, cur)) return;
    f32x4 acc[2][2][4][2];
#pragma unroll
    for (int a = 0; a < 2; ++a)
#pragma unroll
        for (int b = 0; b < 2; ++b)
#pragma unroll
            for (int m = 0; m < 4; ++m)
#pragma unroll
                for (int n = 0; n < 2; ++n) acc[a][b][m][n] = (f32x4){0.f, 0.f, 0.f, 0.f};
    bf16x8 At[4][2], B0[2][2], B1[2][2];
    const char* cA = (const char*)g.A + ((size_t)cur.pm * BM * g.lda + (size_t)cur.ks * K) * 2;
    const char* cB = (const char*)g.Bt + ((size_t)cur.pn * BM * g.ldb + (size_t)cur.ks * K) * 2;
    PG8_STAGE(PG8_SB(0, 0), cB, voffB); PG8_STAGE(PG8_SB(0, 1), cB + hB, voffB); PG8_STAGE(PG8_SA(0, 0), cA, voffA); PG8_STAGE(PG8_SA(0, 1), cA + hA, voffA);
    if (wr == 1) PG8_BAR;
    PG8_WAIT_V(2); PG8_BAR;
    PG8_STAGE(PG8_SB(1, 0), cB + kstep, voffB); PG8_STAGE(PG8_SA(1, 0), cA + kstep, voffA); PG8_STAGE(PG8_SB(1, 1), cB + hB + kstep, voffB);
    if constexpr (Epi::HAS_PREFETCH) E.prefetch(cur, wr, wc, fr, fq, lds + STAGE_BYTES + 1024 + wid * 1024);
    PG8_WAIT_V(6); PG8_BAR;
    for (;;) {
        const bool has_next = S.next(ui + 1, nxt);
        const char* nA = has_next ? (const char*)g.A + ((size_t)nxt.pm * BM * g.lda + (size_t)nxt.ks * K) * 2 : cA;
        const char* nB = has_next ? (const char*)g.Bt + ((size_t)nxt.pn * BM * g.ldb + (size_t)nxt.ks * K) * 2 : cB;
        for (int t = 0; t < nt; t += 2) {
            const bool last = (t == nt - 2);
            const char* a1 = cA + (size_t)(t + 1) * kstep;
            const char* a2 = last ? nA : cA + (size_t)(t + 2) * kstep; const char* b2 = last ? nB : cB + (size_t)(t + 2) * kstep;
            const char* a3 = a2 + kstep; const char* b3 = b2 + kstep;
            PG8_LDB(B0, 0, 0); PG8_LDB(B1, 0, 1); PG8_SCHED; PG8_LDA(At, 0, 0); PG8_STAGE(PG8_SA(1, 1), a1 + hA, voffA);
            PG8_WAIT_V(8); PG8_WAIT_L(0); PG8_BAR; PG8_MMA(0, 0, At, B0); PG8_MMA(0, 1, At, B1); PG8_BAR; PG8_SCHED;
            PG8_LDA(At, 0, 1); PG8_STAGE(PG8_SB(0, 0), b2, voffB); PG8_STAGE(PG8_SB(0, 1), b2 + hB, voffB); PG8_STAGE(PG8_SA(0, 0), a2, voffA);
            PG8_WAIT_V(8); PG8_WAIT_L(0); PG8_BAR; PG8_MMA(1, 0, At, B0); PG8_MMA(1, 1, At, B1); PG8_BAR; PG8_SCHED;
            PG8_LDB(B0, 1, 0); PG8_LDB(B1, 1, 1); PG8_SCHED; PG8_LDA(At, 1, 0); PG8_STAGE(PG8_SA(0, 1), a2 + hA, voffA);
            PG8_WAIT_V(8); PG8_WAIT_L(0); PG8_BAR; PG8_MMA(0, 0, At, B0); PG8_MMA(0, 1, At, B1); PG8_BAR; PG8_SCHED;
            PG8_LDA(At, 1, 1); PG8_STAGE(PG8_SB(1, 0), b3, voffB); PG8_STAGE(PG8_SB(1, 1), b3 + hB, voffB); PG8_STAGE(PG8_SA(1, 0), a3, voffA);
            PG8_WAIT_V(8); PG8_WAIT_L(0); PG8_BAR; PG8_MMA(1, 0, At, B0); PG8_MMA(1, 1, At, B1); PG8_BAR; PG8_SCHED;
            if constexpr (Epi::HAS_MID) { if (t + 2 == (nt >> 1)) E.mid(acc, cur, wr, wc, fr, fq); }
        }
        if constexpr (ALIGN_EPI) { if (wr == 0) PG8_BAR; }
        E(acc, cur, wr, wc, fr, fq);
        S.done(ui);
        if (!has_next) break;
#pragma unroll
        for (int a = 0; a < 2; ++a)
#pragma unroll
            for (int b = 0; b < 2; ++b)
#pragma unroll
                for (int m = 0; m < 4; ++m)
#pragma unroll
                    for (int n = 0; n < 2; ++n) acc[a][b][m][n] = (f32x4){0.f, 0.f, 0.f, 0.f};
        cur = nxt; cA = nA; cB = nB; ++ui;
        if constexpr (ALIGN_EPI) { if (wr == 1) PG8_BAR; }
    }
    PG8_WAIT_V(0);
    if constexpr (!ALIGN_EPI) { if (wr == 0) PG8_BAR; }
    PG8_BAR;
#undef PG8_SA
#undef PG8_SB
#undef PG8_STAGE
#undef PG8_LDA
#undef PG8_LDB
#undef PG8_MMA
#undef PG8_WAIT_V
#undef PG8_WAIT_L
#undef PG8_BAR
#undef PG8_SCHED
}
}


#define XB_TMO      128
#define XB_XCNT(j)  (256  + 64 * (j))
#define XB_XSUB(j)  (1280 + 64 * (j))
#define XB_XGEN(j)  (2304 + 64 * (j))
#define XB_TOP      3328
#define XB_TOPGEN   3392
#define XCD_BAR_WORDS 3456
#define XB_SPIN_CAP (1u << 18)
__device__ __forceinline__ unsigned xb_ld(unsigned* p)              { return __hip_atomic_load(p, __ATOMIC_RELAXED, __HIP_MEMORY_SCOPE_AGENT); }
__device__ __forceinline__ unsigned xb_add(unsigned* p, unsigned v) { return __hip_atomic_fetch_add(p, v, __ATOMIC_RELAXED, __HIP_MEMORY_SCOPE_AGENT); }
__device__ __forceinline__ unsigned xb_xcc_id() { return (unsigned)__builtin_amdgcn_s_getreg((3 << 11) | 20) & 0xFu; }
#define XB_SPIN(cond, bar) do { unsigned _sp = 0; while (cond) { __builtin_amdgcn_s_sleep(1); \
    if ((++_sp & 255u) == 0u) { if (xb_ld(&(bar)[XB_TMO])) break; if (_sp > XB_SPIN_CAP) { atomicAdd(&(bar)[XB_TMO], 1u); break; } } } } while (0)
struct XcdBarrier { unsigned* bar; unsigned x; volatile LAS unsigned* st; int wave; };
__device__ __forceinline__ XcdBarrier xcd_barrier_post(unsigned* bar, volatile LAS unsigned* st, int wave) {
    XcdBarrier b; b.bar = bar; b.x = xb_xcc_id(); b.st = st; b.wave = wave;
    if (wave == 0 && lane_id() == 0) (void)xb_add(&bar[XB_XCNT(b.x)], 1u);
    return b;
}
__device__ __forceinline__ void xcd_barrier_complete(unsigned* bar, unsigned x, unsigned& nloc, unsigned& nx) {
    const unsigned G = gridDim.x * gridDim.y * gridDim.z;
    unsigned sum, cnt, mine, sp = 0u;
    for (;;) {
        sum = 0u; cnt = 0u; mine = 0u;
#pragma unroll
        for (unsigned j = 0; j < 16; ++j) { const unsigned c = xb_ld(&bar[XB_XCNT(j)]); sum += c; cnt += (c > 0u) ? 1u : 0u; mine = (j == x) ? c : mine; }
        if (sum == G) break;
        __builtin_amdgcn_s_sleep(1);
        if ((++sp & 255u) == 0u) { if (xb_ld(&bar[XB_TMO])) break; if (sp > XB_SPIN_CAP) { atomicAdd(&bar[XB_TMO], 1u); break; } }
    }
    nloc = mine > 0u ? mine : 1u; nx = cnt > 0u ? cnt : 1u;
}
__device__ __forceinline__ void xcd_barrier(const XcdBarrier& b) {
    asm volatile("s_waitcnt vmcnt(0)" ::: "memory");
    __syncthreads();
    if (b.wave == 0 && lane_id() == 0) {
        unsigned* bar = b.bar;
        __builtin_amdgcn_s_waitcnt(0);
        unsigned nloc = b.st[0], nx = b.st[1];
        if (nloc == 0u) { xcd_barrier_complete(bar, b.x, nloc, nx); b.st[0] = nloc; b.st[1] = nx; }
        const unsigned old = xb_add(&bar[XB_XSUB(b.x)], 1u);
        const unsigned gen = old / nloc;
        if (old + 1u == (gen + 1u) * nloc) {
            __builtin_amdgcn_fence(__ATOMIC_RELEASE, "agent");
            asm volatile("s_waitcnt vmcnt(0)" ::: "memory");
            const unsigned og = xb_add(&bar[XB_TOP], 1u);
            const unsigned tg = og / nx;
            if (og + 1u == (tg + 1u) * nx) xb_add(&bar[XB_TOPGEN], 1u);
            else XB_SPIN(xb_ld(&bar[XB_TOPGEN]) == tg, bar);
            __builtin_amdgcn_fence(__ATOMIC_ACQUIRE, "agent");
            xb_add(&bar[XB_XGEN(b.x)], 1u);
            asm volatile("s_waitcnt vmcnt(0)" ::: "memory");
        } else {
            XB_SPIN(xb_ld(&bar[XB_XGEN(b.x)]) == gen, bar);
            __builtin_amdgcn_fence(__ATOMIC_ACQUIRE, "agent");
            asm volatile("s_waitcnt vmcnt(0)" ::: "memory");
        }
    }
    __syncthreads();
}

struct Params {
    const float* in[23];
    float* out;
    unsigned char* ws;
    int ph_lo, ph_hi;
};
enum { I_X = 0, I_NORM_ATTN, I_W_IN, I_FOX_F_BIAS, I_FOX_Q_GAIN, I_FOX_K_GAIN, I_NSA_Q_GAIN, I_NSA_KC_GAIN, I_NSA_KS_GAIN, I_NSA_KW_GAIN,
       I_PE_K, I_W1_K, I_W2_K, I_PE_V, I_W1_V, I_W2_V, I_W_UP_FOX, I_W_UP_NSA, I_W_OUT, I_NORM_FFN, I_W_GATE, I_W_UP, I_W_DOWN };

typedef float f32x2_t_ __attribute__((ext_vector_type(2))); typedef __bf16 bf16x2_t_ __attribute__((ext_vector_type(2)));
__device__ __forceinline__ unsigned cvtpk2(float lo, float hi) { f32x2_t_ v = {lo, hi}; bf16x2_t_ b = __builtin_convertvector(v, bf16x2_t_); return __builtin_bit_cast(unsigned, b); }
__device__ __forceinline__ u32x4 pack8(const f32x4& a, const f32x4& b) { return (u32x4){cvtpk2(a[0], a[1]), cvtpk2(a[2], a[3]), cvtpk2(b[0], b[1]), cvtpk2(b[2], b[3])}; }
struct EpiProj {
    static constexpr bool PERM = true, HAS_MID = false, HAS_PREFETCH = false;
    unsigned char* ws; const float* ksg; const float* kwg;
    __device__ __forceinline__ void operator()(const f32x4 (&acc)[2][2][4][2], const pg8::Unit& u, int wr, int wc, int fr, int fq) const {
#pragma unroll
        for (int bj = 0; bj < 2; ++bj) {
            const int c0 = u.pn * 256 + bj * 128;
            int kind = 0, pitch = 0, coff = 0; size_t base = 0;
            const float* kg = nullptr;
            int slot = -1;
            if (c0 < 1024) { base = WS_FQ; pitch = 1024; coff = c0; }
            else if (c0 < 2048) { base = WS_FK; pitch = 1024; coff = c0 - 1024; slot = coff >> 7; }
            else if (c0 < 3072) { base = WS_FV; pitch = 1024; coff = c0 - 2048; }
            else if (c0 < 4608) { base = WS_NQ; pitch = 1536; coff = c0 - 3072; }
            else if (c0 < 4992) { kind = 1; coff = c0 - 4608; }
            else if (c0 < 5376) { base = WS_KS; pitch = 384; coff = c0 - 4992; slot = 8 + ((coff + wc * 32) >= 192 ? 1 : 0); kg = ksg; }
            else if (c0 < 5760) { base = WS_KW; pitch = 384; coff = c0 - 5376; slot = 10 + ((coff + wc * 32) >= 192 ? 1 : 0); kg = kwg; }
            else if (c0 < 6016) { kind = 2; coff = c0 - 5760; }
            else if (c0 < 6272) { base = WS_VS; pitch = 256; coff = c0 - 6016; }
            else if (c0 < 6528) { base = WS_VW; pitch = 256; coff = c0 - 6272; }
            else if (c0 < 6656) { kind = 3; }
            else if (c0 < 8704) { base = WS_GA; pitch = 2048; coff = c0 - 6656; }
            else { base = WS_GB; pitch = 2048; coff = c0 - 8704; }
            const int cw = wc * 32 + fq * 8;
            f32x4 kg0 = {1.f, 1.f, 1.f, 1.f}, kg1 = {1.f, 1.f, 1.f, 1.f};
            if (kg) { const int d = (coff + cw) % 192; kg0 = *(const f32x4*)(kg + d); kg1 = *(const f32x4*)(kg + d + 4); }
#pragma unroll
            for (int ai = 0; ai < 2; ++ai)
#pragma unroll
                for (int m = 0; m < 4; ++m) { const int row = u.pm * 256 + ai * 128 + wr * 64 + m * 16 + fr;
                    f32x4 v0 = acc[ai][bj][m][0], v1 = acc[ai][bj][m][1];
                    if (slot >= 0) {
                        float ss = ((v0[0] * v0[0] + v0[1] * v0[1]) + (v0[2] * v0[2] + v0[3] * v0[3])) + ((v1[0] * v1[0] + v1[1] * v1[1]) + (v1[2] * v1[2] + v1[3] * v1[3]));
                        ss += __shfl_xor(ss, 16); ss += __shfl_xor(ss, 32);
                        if (fq == 0) atomicAdd((float*)(ws + WS_SSQ) + (size_t)slot * MTOK + row, ss); }
                    if (kg) { v0 *= kg0; v1 *= kg1; }
                    if (kind == 3) { if (cw < 32) { float* sp = (float*)(ws + WS_SMALL) + (size_t)row * 32 + cw; *(f32x4*)sp = v0; *(f32x4*)(sp + 4) = v1; } continue; }
                    bf16* p;
                    if (kind == 0) p = (bf16*)(ws + base) + (size_t)row * pitch + coff + cw;
                    else if (kind == 1) { const int cc = coff + cw, g = cc >= 192 ? 1 : 0, d = cc - 192 * g; p = (bf16*)(ws + WS_KC) + ((size_t)(row + (row >> 11) * SEQ + g * SEQ)) * 192 + d; }
                    else { const int g = coff >> 7; p = (bf16*)(ws + WS_VC) + ((size_t)(row + (row >> 11) * SEQ + g * SEQ)) * 128 + cw; }
                    if (c0 >= 6656) __builtin_nontemporal_store(pack8(v0, v1), (u32x4*)p); else *(u32x4*)p = pack8(v0, v1); }
        }
    }
};
struct EpiSlab {
    static constexpr bool PERM = true, HAS_MID = false, HAS_PREFETCH = false;
    float* slab;
    __device__ __forceinline__ void operator()(const f32x4 (&acc)[2][2][4][2], const pg8::Unit& u, int wr, int wc, int fr, int fq) const {
#pragma unroll
        for (int ai = 0; ai < 2; ++ai)
#pragma unroll
            for (int m = 0; m < 4; ++m) { const int row = u.pm * 256 + ai * 128 + wr * 64 + m * 16 + fr; float* rp = slab + ((size_t)u.ks * CROWS + row) * 256 + wc * 32 + fq * 8;
#pragma unroll
                for (int bj = 0; bj < 2; ++bj) { *(f32x4*)(rp + bj * 128) = acc[ai][bj][m][0]; *(f32x4*)(rp + bj * 128 + 4) = acc[ai][bj][m][1]; } }
    }
};
__device__ __forceinline__ float clampf(float v, float lo, float hi) { return fminf(fmaxf(v, lo), hi); }
__device__ __forceinline__ float gl(unsigned w, int hi) { return clampf(__uint_as_float(hi ? (w & 0xffff0000u) : (w << 16)), -30.f, 30.f); }
#define EPI_ROW(gi) ((size_t)(u.pm * 256 + ((gi) >> 2) * 128 + wr * 64 + ((gi) & 3) * 16 + fr))
#define EPI_FENCE() asm volatile("" ::: "memory")
#define EPI_PF(ptr) __builtin_amdgcn_global_load_lds((const unsigned*)(ptr), (LAS unsigned*)junk, 16, 0, 0)
struct EpiMerge {
    static constexpr bool PERM = true, HAS_MID = true, HAS_PREFETCH = false;
    const bf16* GA; const bf16* GB; bf16* MG;
    __device__ __forceinline__ void prefetch(const pg8::Unit& u, int wr, int wc, int fr, int fq, LAS unsigned char* junk) const {
        const size_t cbase = (size_t)(u.pn * 256 + wc * 32 + fq * 8);
#pragma unroll
        for (int gi = 0; gi < 8; ++gi) { const size_t o_ = EPI_ROW(gi) * 2048 + cbase; EPI_PF(GA + o_); EPI_PF(GA + o_ + 128); EPI_PF(GB + o_); EPI_PF(GB + o_ + 128); }
    }
    __device__ __forceinline__ void mid(f32x4 (&acc)[2][2][4][2], const pg8::Unit& u, int wr, int wc, int fr, int fq) const {
        int zero; asm volatile("v_mov_b32 %0, 0" : "=v"(zero));
        const size_t cbase = (size_t)(u.pn * 256 + wc * 32 + fq * 8 + zero);
#pragma unroll
        for (int hf = 0; hf < 2; ++hf) {
            u32x4 a[8], b[8];
#pragma unroll
            for (int i = 0; i < 8; ++i) { const int st = 8 * hf + i; const size_t o_ = EPI_ROW(st >> 1) * 2048 + cbase + (st & 1) * 128; a[i] = *(const u32x4*)(GA + o_); b[i] = *(const u32x4*)(GB + o_); }
#pragma unroll
            for (int i = 0; i < 8; ++i) { const int st = 8 * hf + i;
#pragma unroll
                for (int e = 0; e < 8; ++e) { const float ga_ = gl(a[i][e >> 1], e & 1), gb_ = gl(b[i][e >> 1], e & 1);
                    acc[st >> 3][st & 1][(st >> 1) & 3][e >> 2][e & 3] *= (1.f + __expf(-gb_)) * __builtin_amdgcn_rcpf(1.f + __expf(-ga_)); } }
            EPI_FENCE();
        }
    }
    __device__ __forceinline__ void operator()(const f32x4 (&acc)[2][2][4][2], const pg8::Unit& u, int wr, int wc, int fr, int fq) const {
        const size_t cbase = (size_t)(u.pn * 256 + wc * 32 + fq * 8);
        u32x4 b0[2], b1[2];
#define MG_LDB(B, gi) do { const size_t o_ = EPI_ROW(gi) * 2048 + cbase; B[0] = *(const u32x4*)(GB + o_); B[1] = *(const u32x4*)(GB + o_ + 128); } while (0)
#define MG_FIN(B, gi) do { _Pragma("unroll") for (int bj = 0; bj < 2; ++bj) { f32x4 o0, o1; \
            _Pragma("unroll") for (int e = 0; e < 4; ++e) { o0[e] = acc[(gi) >> 2][bj][(gi) & 3][0][e] * __builtin_amdgcn_rcpf(1.f + __expf(-gl(B[bj][e >> 1], e & 1))); \
                                                            o1[e] = acc[(gi) >> 2][bj][(gi) & 3][1][e] * __builtin_amdgcn_rcpf(1.f + __expf(-gl(B[bj][2 + (e >> 1)], e & 1))); } \
            *(u32x4*)(MG + EPI_ROW(gi) * 2048 + cbase + bj * 128) = pack8(o0, o1); } } while (0)
        MG_LDB(b0, 0);
#pragma unroll
        for (int gi = 0; gi < 8; gi += 2) {
            MG_LDB(b1, gi + 1); MG_FIN(b0, gi); EPI_FENCE();
            if (gi + 2 < 8) MG_LDB(b0, gi + 2);
            MG_FIN(b1, gi + 1); EPI_FENCE();
        }
#undef MG_LDB
#undef MG_FIN
    }
};
struct EpiOut {
    static constexpr bool PERM = true, HAS_MID = false, HAS_PREFETCH = false;
    const float* x; float* out; bf16* HB; float* sumsq;
    __device__ __forceinline__ void prefetch(const pg8::Unit& u, int wr, int wc, int fr, int fq, LAS unsigned char* junk) const {
        const size_t cbase = (size_t)(u.pn * 256 + wc * 32 + fq * 8);
#pragma unroll
        for (int gi = 0; gi < 8; ++gi) { const float* p_ = x + EPI_ROW(gi) * 2048 + cbase; EPI_PF(p_); EPI_PF(p_ + 4); EPI_PF(p_ + 128); EPI_PF(p_ + 132); }
    }
    __device__ __forceinline__ void operator()(const f32x4 (&acc)[2][2][4][2], const pg8::Unit& u, int wr, int wc, int fr, int fq) const {
        const size_t cbase = (size_t)(u.pn * 256 + wc * 32 + fq * 8);
        f32x4 x0[4], x1[4];
#define EO_LD(X, gi) do { const float* p_ = x + EPI_ROW(gi) * 2048 + cbase; X[0] = *(const f32x4*)p_; X[1] = *(const f32x4*)(p_ + 4); X[2] = *(const f32x4*)(p_ + 128); X[3] = *(const f32x4*)(p_ + 132); } while (0)
#define EO_DO(X, gi) do { const size_t off_ = EPI_ROW(gi) * 2048 + cbase; float ss = 0.f; \
        _Pragma("unroll") for (int bj = 0; bj < 2; ++bj) { const f32x4 h0 = X[2 * bj] + acc[(gi) >> 2][bj][(gi) & 3][0], h1 = X[2 * bj + 1] + acc[(gi) >> 2][bj][(gi) & 3][1]; \
            ss += ((h0[0] * h0[0] + h0[1] * h0[1]) + (h0[2] * h0[2] + h0[3] * h0[3])) + ((h1[0] * h1[0] + h1[1] * h1[1]) + (h1[2] * h1[2] + h1[3] * h1[3])); \
            *(u32x4*)(HB + off_ + bj * 128) = pack8(h0, h1); } \
        ss += __shfl_xor(ss, 16); ss += __shfl_xor(ss, 32); if (fq == 0) atomicAdd(sumsq + EPI_ROW(gi), ss); } while (0)
        EO_LD(x0, 0);
#pragma unroll
        for (int gi = 0; gi < 8; gi += 2) {
            EO_LD(x1, gi + 1); EO_DO(x0, gi); EPI_FENCE();
            if (gi + 2 < 8) EO_LD(x0, gi + 2);
            EO_DO(x1, gi + 1); EPI_FENCE();
        }
#undef EO_LD
#undef EO_DO
    }
};
struct EpiFfn {
    static constexpr bool PERM = true, HAS_MID = false, HAS_PREFETCH = false;
    const float* sumsq; bf16* ACT;
    __device__ __forceinline__ void operator()(const f32x4 (&acc)[2][2][4][2], const pg8::Unit& u, int wr, int wc, int fr, int fq) const {
        float sq[8];
#pragma unroll
        for (int gi = 0; gi < 8; ++gi) sq[gi] = sumsq[EPI_ROW(gi)];
#pragma unroll
        for (int gi = 0; gi < 8; ++gi) { const int ai = gi >> 2, m = gi & 3;
            const float r = 1.0f / sqrtf(sq[gi] * (1.0f / DM) + EPS);
            f32x4 o[2];
#pragma unroll
            for (int n = 0; n < 2; ++n)
#pragma unroll
                for (int e = 0; e < 4; ++e) { const float gg = acc[ai][0][m][n][e] * r, uu = acc[ai][1][m][n][e] * r; o[n][e] = gg * __builtin_amdgcn_rcpf(1.f + __expf(-gg)) * uu; }
            *(u32x4*)(ACT + EPI_ROW(gi) * DFF + u.pn * 128 + wc * 32 + fq * 8) = pack8(o[0], o[1]); }
    }
};
struct EpiDown {
    static constexpr bool PERM = true, HAS_MID = false, HAS_PREFETCH = false;
    float* out; const bf16* HB;
    __device__ __forceinline__ void prefetch(const pg8::Unit& u, int wr, int wc, int fr, int fq, LAS unsigned char* junk) const {}
    __device__ __forceinline__ void operator()(const f32x4 (&acc)[2][2][4][2], const pg8::Unit& u, int wr, int wc, int fr, int fq) const {
        const size_t cbase = (size_t)(u.pn * 256 + wc * 32 + fq * 8);
        u32x4 x0[2], x1[2];
#define ED_LD(X, gi) do { const bf16* p_ = HB + EPI_ROW(gi) * 2048 + cbase; X[0] = *(const u32x4*)p_; X[1] = *(const u32x4*)(p_ + 128); } while (0)
#define ED_LO(w) __uint_as_float((w) << 16)
#define ED_HI(w) __uint_as_float((w) & 0xffff0000u)
#define ED_DO(X, gi) do { float* p_ = out + EPI_ROW(gi) * 2048 + cbase; \
        _Pragma("unroll") for (int bj = 0; bj < 2; ++bj) { \
            const f32x4 r0 = {ED_LO(X[bj].x), ED_HI(X[bj].x), ED_LO(X[bj].y), ED_HI(X[bj].y)}, r1 = {ED_LO(X[bj].z), ED_HI(X[bj].z), ED_LO(X[bj].w), ED_HI(X[bj].w)}; \
            __builtin_nontemporal_store(r0 + acc[(gi) >> 2][bj][(gi) & 3][0], (f32x4*)(p_ + bj * 128)); \
            __builtin_nontemporal_store(r1 + acc[(gi) >> 2][bj][(gi) & 3][1], (f32x4*)(p_ + bj * 128 + 4)); } } while (0)
        ED_LD(x0, 0);
#pragma unroll
        for (int gi = 0; gi < 8; gi += 2) {
            ED_LD(x1, gi + 1); ED_DO(x0, gi); EPI_FENCE();
            if (gi + 2 < 8) ED_LD(x0, gi + 2);
            ED_DO(x1, gi + 1); EPI_FENCE();
        }
#undef ED_LD
#undef ED_DO
#undef ED_LO
#undef ED_HI
    }
};

__device__ __forceinline__ int win_src(int n) {
    if (n < 3072) return n;
    if (n < 4608) return n + 8;
    if (n < 4992) return 4616 + (n - 4608);
    if (n < 5376) return 5256 + (n - 4992);
    if (n < 5760) return 5896 + (n - 5376);
    if (n < 6016) return 5000 + (n - 5760);
    if (n < 6272) return 5640 + (n - 6016);
    if (n < 6528) return 6280 + (n - 6272);
    if (n < 6536) return 3072 + (n - 6528);
    if (n < 6560) return n;
    if (n < 6656) return -1;
    if (n < 8704) return 6560 + (n - 6656);
    return 8608 + (n - 8704);
    return -1;
}
struct TrDesc { const float* src; const float* gain; bf16* dst; int nsrc; int ldT; int valid; };
template <int MAP> __device__ __forceinline__ TrDesc tr_desc(const float* W, const float* W2, int Nsrc, bf16* WT, int ldT, int kdst, const float* gain, int nbn, int item, int lane) {
    const int kb = item / nbn, nb = item - kb * nbn, k0 = 64 * kb, n0 = 32 * nb;
    const int nd = n0 + 4 * (lane & 7);
    const float* src = W; int col = nd;
    if (MAP == 1) col = win_src(nd);
    if (MAP == 2) { const int tile = nd >> 8, w = nd & 255; if (w < 128) col = tile * 128 + w; else { col = tile * 128 + w - 128; src = W2; } }
    TrDesc d; d.valid = col >= 0; d.src = src + (size_t)(k0 + (lane >> 3)) * Nsrc + (col >= 0 ? col : 0); d.gain = gain ? gain + k0 + (lane >> 3) : nullptr;
    d.dst = WT + (size_t)n0 * ldT + kdst + k0; d.nsrc = Nsrc; d.ldT = ldT; return d;
}
template <bool NT = false> __device__ __forceinline__ void tr_load(const TrDesc& d, f32x4 (&v)[8]) {
#pragma unroll
    for (int i = 0; i < 8; ++i) { const f32x4* p_ = (const f32x4*)(d.src + (size_t)(8 * i) * d.nsrc); v[i] = d.valid ? (NT ? __builtin_nontemporal_load(p_) : *p_) : (f32x4){0.f, 0.f, 0.f, 0.f}; }
}
template <bool NT = false> __device__ __forceinline__ void tr_write(const TrDesc& d, const f32x4 (&v)[8], LAS float* scr, int lane) {
#pragma unroll
    for (int i = 0; i < 8; ++i) { const int kk = 8 * i + (lane >> 3); const float g = d.gain ? d.gain[8 * i] : 1.f; LAS float* w_ = scr + kk * 33 + 4 * (lane & 7);
        w_[0] = v[i][0] * g; w_[1] = v[i][1] * g; w_[2] = v[i][2] * g; w_[3] = v[i][3] * g; }
    LDS_WAIT();
    const int c = lane & 7;
#pragma unroll
    for (int j = 0; j < 4; ++j) { const int n = (lane >> 3) + 8 * j; const LAS float* s = scr + (8 * c) * 33 + n;
        u32x4 o; o.x = pk2(s[0 * 33], s[1 * 33]); o.y = pk2(s[2 * 33], s[3 * 33]); o.z = pk2(s[4 * 33], s[5 * 33]); o.w = pk2(s[6 * 33], s[7 * 33]);
        if (NT) __builtin_nontemporal_store(o, (u32x4*)(d.dst + (size_t)n * d.ldT + 8 * c)); else *(u32x4*)(d.dst + (size_t)n * d.ldT + 8 * c) = o; }
    LDS_WAIT();
}
template <bool NTW, class F> __device__ __forceinline__ void tr_pipeline3(F desc, int it0, int last, int stride, LAS float* scr, int lane) {
    f32x4 v0[8], v1[8], v2[8]; TrDesc d0, d1, d2;
    int a = it0;
    if (a < last) { d0 = desc(a); tr_load<true>(d0, v0); }
    if (a + stride < last) { d1 = desc(a + stride); tr_load<true>(d1, v1); }
    for (;;) {
        if (a >= last) break;
        if (a + 2 * stride < last) { d2 = desc(a + 2 * stride); tr_load<true>(d2, v2); }
        tr_write<NTW>(d0, v0, scr, lane);
        if (a + stride >= last) break;
        if (a + 3 * stride < last) { d0 = desc(a + 3 * stride); tr_load<true>(d0, v0); }
        tr_write<NTW>(d1, v1, scr, lane);
        if (a + 2 * stride >= last) break;
        if (a + 4 * stride < last) { d1 = desc(a + 4 * stride); tr_load<true>(d1, v1); }
        tr_write<NTW>(d2, v2, scr, lane);
        a += 3 * stride;
    }
}
__device__ __forceinline__ void xn_row(const float* xrow, const float* gain, bf16* orow, int lane) {
    const f32x4* xr = (const f32x4*)xrow + lane; const f32x4* gr = (const f32x4*)gain + lane;
    f32x4 v[8]; float s = 0.f;
#pragma unroll
    for (int j = 0; j < 8; ++j) { v[j] = xr[64 * j]; s += (v[j][0] * v[j][0] + v[j][1] * v[j][1]) + (v[j][2] * v[j][2] + v[j][3] * v[j][3]); }
    const float r = 1.0f / sqrtf(wsum(s) * (1.0f / DM) + EPS);
    unsigned long long* o8 = (unsigned long long*)orow + lane;
#pragma unroll
    for (int j = 0; j < 8; ++j) { const f32x4 g = gr[64 * j]; const f32x4 o = v[j] * r * g;
        o8[64 * j] = (unsigned long long)pk2(o[0], o[1]) | ((unsigned long long)pk2(o[2], o[3]) << 32); }
}

__device__ __forceinline__ void xn_row2(const float* xrow, const float* gain, bf16* orow, size_t stride, bool two, int lane) {
    const f32x4* xr = (const f32x4*)xrow + lane; const f32x4* gr = (const f32x4*)gain + lane;
    f32x4 v[8], v2[8]; float s = 0.f, s2 = 0.f;
#pragma unroll
    for (int j = 0; j < 8; ++j) { v[j] = __builtin_nontemporal_load(xr + 64 * j); v2[j] = two ? __builtin_nontemporal_load((const f32x4*)(xrow + stride) + lane + 64 * j) : (f32x4){0.f, 0.f, 0.f, 0.f}; }
#pragma unroll
    for (int j = 0; j < 8; ++j) { s += (v[j][0] * v[j][0] + v[j][1] * v[j][1]) + (v[j][2] * v[j][2] + v[j][3] * v[j][3]); s2 += (v2[j][0] * v2[j][0] + v2[j][1] * v2[j][1]) + (v2[j][2] * v2[j][2] + v2[j][3] * v2[j][3]); }
    const float r = 1.0f / sqrtf(wsum(s) * (1.0f / DM) + EPS), r2 = 1.0f / sqrtf(wsum(s2) * (1.0f / DM) + EPS);
    unsigned long long* o8 = (unsigned long long*)orow + lane; unsigned long long* o82 = (unsigned long long*)(orow + stride) + lane;
#pragma unroll
    for (int j = 0; j < 8; ++j) { const f32x4 g = gr[64 * j]; const f32x4 o = v[j] * r * g, o2 = v2[j] * r2 * g;
        o8[64 * j] = (unsigned long long)pk2(o[0], o[1]) | ((unsigned long long)pk2(o[2], o[3]) << 32);
        if (two) o82[64 * j] = (unsigned long long)pk2(o2[0], o2[1]) | ((unsigned long long)pk2(o2[2], o2[3]) << 32); }
}

constexpr int LDS_BYTES = 147456;
constexpr int NWAVES = 8, NTHREADS = 512;

__device__ __forceinline__ void touch_range(const unsigned char* base, size_t bytes, int gw, int NGW, int lane) {
    const size_t nvec = bytes >> 4;
    for (size_t i = (size_t)gw * 64 * 8 + lane; i < nvec; i += (size_t)NGW * 64 * 8) {
        u32x4 t[8];
#pragma unroll
        for (int e = 0; e < 8; ++e) { const size_t j = i + (size_t)e * 64; t[e] = j < nvec ? *(const u32x4*)(base + (j << 4)) : (u32x4){0u, 0u, 0u, 0u}; }
#pragma unroll
        for (int e = 0; e < 8; ++e) asm volatile("" :: "v"(t[e]));
    }
}

enum { PH_P0 = 0, PH_GEMM1, PH_P2A, PH_P2B, PH_ATTN, PH_MERGE, PH_OUT, PH_FFN, PH_DOWN, PH_N };

__device__ __forceinline__ void phase_mix_weights(const Params& p, LAS unsigned char* lds, int cw, int NCW, int wave, int lane) {
    unsigned char* ws = p.ws;
    LAS float* scr = (LAS float*)(lds + wave * 16384);
    constexpr int I_WU = 16 * 64, I_WOUT = 32 * 64, NIT = 2 * I_WU + I_WOUT;
    auto desc = [&](int it) -> TrDesc {
        int r = it;
        if (r < I_WU) return tr_desc<0>(p.in[I_W_UP_FOX], nullptr, 2048, (bf16*)(ws + WS_WU), 2048, 0, nullptr, 64, r, lane);
        r -= I_WU;
        if (r < I_WU) return tr_desc<0>(p.in[I_W_UP_NSA], nullptr, 2048, (bf16*)(ws + WS_WU), 2048, 1024, nullptr, 64, r, lane);
        r -= I_WU;
        return tr_desc<0>(p.in[I_W_OUT], nullptr, 2048, (bf16*)(ws + WS_WOUT), 2048, 0, nullptr, 64, r, lane);
    };
    tr_pipeline3<false>(desc, cw, NIT, NCW, scr, lane);
}

__device__ __forceinline__ void phase_p0(const Params& p, LAS unsigned char* lds, int gw, int NGW, int wave, int lane) {
    unsigned char* ws = p.ws;
    LAS float* scr = (LAS float*)(lds + wave * 16384);
    constexpr int I_WIN = 32 * (DINP / 32), I_C1K = 96 * 8, I_C1V = 64 * 8;
    constexpr int NIT = I_WIN + I_C1K + I_C1V;
    auto desc = [&](int it) -> TrDesc {
        int r = it;
        if (r < I_WIN) return tr_desc<1>(p.in[I_W_IN], nullptr, DIN, (bf16*)(ws + WS_WIN), 2048, 0, nullptr, DINP / 32, r, lane);
        r -= I_WIN;
        if (r < I_C1K) return tr_desc<0>(p.in[I_W1_K], nullptr, 256, (bf16*)(ws + WS_CW1K), 6144, 0, nullptr, 8, r, lane);
        r -= I_C1K;
        return tr_desc<0>(p.in[I_W1_V], nullptr, 256, (bf16*)(ws + WS_CW1V), 4096, 0, nullptr, 8, r, lane);
    };
    tr_pipeline3<false>(desc, gw, NIT, NGW, scr, lane);
    for (int m = gw; m < MTOK; m += 2 * NGW) xn_row2(p.in[I_X] + (size_t)m * DM, p.in[I_NORM_ATTN], (bf16*)(ws + WS_XN) + (size_t)m * DM, (size_t)NGW * DM, m + NGW < MTOK, lane);
    for (int s = (NGW == 2048 ? gw - 1792 : gw); s >= 0 && s < 96 + 64; s += NGW) {
        const bool isv = s >= 96; const int sl = isv ? s - 96 : s;
        const float* pe = p.in[isv ? I_PE_V : I_PE_K] + sl * 64; const float* w = p.in[isv ? I_W1_V : I_W1_K] + (size_t)sl * 64 * 256 + 4 * lane;
        f32x4 a = {0.f, 0.f, 0.f, 0.f};
        for (int k0 = 0; k0 < 64; k0 += 16) { f32x4 t[16]; float pv[16];
#pragma unroll
            for (int e = 0; e < 16; ++e) { t[e] = *(const f32x4*)(w + (size_t)(k0 + e) * 256); pv[e] = pe[k0 + e]; }
#pragma unroll
            for (int e = 0; e < 16; ++e) a += t[e] * pv[e]; }
        *(f32x4*)((float*)(ws + (isv ? WS_BPV : WS_BPK)) + sl * 256 + 4 * lane) = a;
    }
    if (gw == NGW - 1) {
        const float* fq = p.in[I_FOX_Q_GAIN]; const float* fk = p.in[I_FOX_K_GAIN]; const float* nq = p.in[I_NSA_Q_GAIN]; const float* ks = p.in[I_NSA_KS_GAIN]; const float* kw = p.in[I_NSA_KW_GAIN];
        const float a = wmaxf(fmaxf(fabsf(fq[lane] * fk[lane]), fabsf(fq[lane + 64] * fk[lane + 64])));
        const float q = wmaxf(fmaxf(fmaxf(fabsf(nq[lane]), fabsf(nq[lane + 64])), fabsf(nq[lane + 128])));
        const float s2 = wmaxf(fmaxf(fmaxf(fabsf(ks[lane]), fabsf(ks[lane + 64])), fabsf(ks[lane + 128])));
        const float w2 = wmaxf(fmaxf(fmaxf(fabsf(kw[lane]), fabsf(kw[lane + 64])), fabsf(kw[lane + 128])));
        if (lane == 0) { float* thr = (float*)(ws + WS_THR); thr[0] = 33.3f * a + 40.f; thr[1] = 40.8f * q * s2 + 40.f; thr[2] = 40.8f * q * w2 + 40.f;
                         thr[3] = 16.65f * a + 40.f; thr[4] = 20.4f * q * s2 + 40.f; thr[5] = 20.4f * q * w2 + 40.f; }
    }
    for (int i = gw * 64 + lane; i < MTOK; i += NGW * 64) ((float*)(ws + WS_SUMSQ))[i] = 0.f;
    for (int i = gw * 64 + lane; i < 12 * MTOK; i += NGW * 64) ((float*)(ws + WS_SSQ))[i] = 0.f;
}

__device__ __forceinline__ float log_sigmoid(float z) { return fminf(z, 0.f) - log1pf(__expf(-fabsf(z))); }

__device__ __forceinline__ float log_sigmoid_fast(float z) { return fminf(z, 0.f) - __logf(1.f + __expf(-fabsf(z))); }
__device__ __forceinline__ void phase_cumsum(const Params& p, int gw, int NGW, int lane) {
    unsigned char* ws = p.ws;
    asm volatile("" : "+v"(lane));
    for (int task = gw; task < BATCH * FH; task += NGW) {
        const int b = task / FH, h = task - b * FH; const float bias = p.in[I_FOX_F_BIAS][h];
        const float* sm = (const float*)(ws + WS_SMALL) + ((size_t)b * SEQ + 32 * lane) * 32 + h;
        float v[32];
#pragma unroll
        for (int i = 0; i < 32; ++i) v[i] = sm[(size_t)i * 32];
        float run = 0.f;
#pragma unroll
        for (int i = 0; i < 32; ++i) { run += log_sigmoid_fast(v[i] + bias); v[i] = run; }
        float incl = run;
#pragma unroll
        for (int o = 1; o < 64; o <<= 1) { const float y = __shfl_up(incl, o); if (lane >= o) incl += y; }
        const float off = incl - run;
        f32x4* cf = (f32x4*)((float*)(ws + WS_CF) + ((size_t)b * FH + h) * SEQ + 32 * lane);
#pragma unroll
        for (int i = 0; i < 8; ++i) cf[i] = (f32x4){v[4 * i] + off, v[4 * i + 1] + off, v[4 * i + 2] + off, v[4 * i + 3] + off};
    }
}
template <bool NTW = true> __device__ __forceinline__ void phase_ffn_weights(const Params& p, LAS unsigned char* lds, int cw, int NCW, int wave, int lane, int first, int last  ) {
    unsigned char* ws = p.ws;
    LAS float* scr = (LAS float*)(lds + wave * 16384);
    constexpr int I_GU = 32 * (NGU / 32), I_D = (DFF / 64) * 64;
    auto desc = [&](int it) -> TrDesc {
        if (it < I_GU) return tr_desc<2>(p.in[I_W_GATE], p.in[I_W_UP], DFF, (bf16*)(ws + WS_WGU), 2048, 0, p.in[I_NORM_FFN], NGU / 32, it, lane);
        return tr_desc<0>(p.in[I_W_DOWN], nullptr, 2048, (bf16*)(ws + WS_WD), DFF, 0, nullptr, 64, it - I_GU, lane);
    };
    tr_pipeline3<NTW>(desc, first + cw, last, NCW, scr, lane);
}

__device__ __forceinline__ void conv_chunk32(const Params& p, LAS unsigned char* lds, int base, int wave, int lane) {
    unsigned char* ws = p.ws;
    LAS float* scr = (LAS float*)(lds + wave * 16384);
    auto desc = [&](int it) -> TrDesc { return tr_desc<2>(p.in[I_W_GATE], p.in[I_W_UP], DFF, (bf16*)(ws + WS_WGU), 2048, 0, p.in[I_NORM_FFN], NGU / 32, it, lane); };
    f32x4 v0[8], v1[8], v2[8], v3[8];
    const TrDesc d0 = desc(base + wave), d1 = desc(base + wave + 8), d2 = desc(base + wave + 16), d3 = desc(base + wave + 24);
    tr_load<true>(d0, v0); tr_load<true>(d1, v1); tr_load<true>(d2, v2); tr_load<true>(d3, v3);
    tr_write<true>(d0, v0, scr, lane); tr_write<true>(d1, v1, scr, lane); tr_write<true>(d2, v2, scr, lane); tr_write<true>(d3, v3, scr, lane);
}
constexpr int CONV_GU_SPLIT = 8192;

__device__ __forceinline__ void cmp_finish_unit(const Params& p, LAS unsigned char* lds, int u, int tid) {
    unsigned char* ws = p.ws;
    asm volatile("" : "+v"(tid));
    const bool isv = u >= 128; const int r0 = (u & 127) * 8;
    const int nsl = isv ? KS_V : KS_K, nbp = isv ? 64 : 96, ncol = isv ? 128 : 192;
    const float* slab = (const float*)(ws + (isv ? WS_HSLV : WS_HSLK)); const float* bp = (const float*)(ws + (isv ? WS_BPV : WS_BPK));
    const float* w2 = p.in[isv ? I_W2_V : I_W2_K];
    LAS float* hid = (LAS float*)lds;
    LAS float* bias = hid + 8 * 256;
    LAS float* ob = bias + 256;
    if (tid < 256) bias[tid] = ((const float*)(ws + WS_BIAS))[(isv ? 256 : 0) + tid];
    __syncthreads();
    for (int idx = tid; idx < 8 * 256; idx += NTHREADS) { const int r = idx >> 8, n = idx & 255; float s = bias[n]; float t[12];
#pragma unroll
        for (int k = 0; k < 12; ++k) t[k] = k < nsl ? slab[((size_t)k * CROWS + r0 + r) * 256 + n] : 0.f;
#pragma unroll
        for (int k = 0; k < 12; ++k) s += t[k];
        hid[idx] = s / (1.f + __expf(-s)); }
    __syncthreads();
    const int c = tid & 255, rg = tid >> 8;
    float a[4] = {0.f, 0.f, 0.f, 0.f};
    if (c < ncol) {
        float w[16], wn[16];
#pragma unroll
        for (int i = 0; i < 16; ++i) w[i] = w2[(size_t)i * ncol + c];
        for (int n0 = 0; n0 < 256; n0 += 16) {
            if (n0 + 16 < 256) {
#pragma unroll
                for (int i = 0; i < 16; ++i) wn[i] = w2[(size_t)(n0 + 16 + i) * ncol + c];
            }
#pragma unroll
            for (int i4 = 0; i4 < 4; ++i4)
#pragma unroll
                for (int r = 0; r < 4; ++r) { const f32x4 h = *(const LAS f32x4*)(hid + (rg * 4 + r) * 256 + n0 + 4 * i4);
                    a[r] += (h[0] * w[4 * i4] + h[1] * w[4 * i4 + 1]) + (h[2] * w[4 * i4 + 2] + h[3] * w[4 * i4 + 3]); }
#pragma unroll
            for (int i = 0; i < 16; ++i) w[i] = wn[i];
        }
        if (isv) {
#pragma unroll
            for (int r = 0; r < 4; ++r) ((bf16*)(ws + WS_VCC))[(size_t)(r0 + rg * 4 + r) * 128 + c] = (bf16)f2bf(a[r]);
        } else {
#pragma unroll
            for (int r = 0; r < 4; ++r) ob[(rg * 4 + r) * 192 + c] = a[r];
        }
    }
    __syncthreads();
    if (!isv) {
        const int w = tid >> 6, lane = tid & 63;
        const float v0 = ob[w * 192 + lane], v1 = ob[w * 192 + 64 + lane], v2 = ob[w * 192 + 128 + lane];
        const float r = 1.0f / sqrtf(wsum(v0 * v0 + v1 * v1 + v2 * v2) * (1.0f / 192.f) + EPS);
        const float* g = p.in[I_NSA_KC_GAIN]; bf16* o = (bf16*)(ws + WS_KCC) + (size_t)(r0 + w) * 192;
        o[lane] = (bf16)f2bf(v0 * r * g[lane]); o[64 + lane] = (bf16)f2bf(v1 * r * g[64 + lane]); o[128 + lane] = (bf16)f2bf(v2 * r * g[128 + lane]);
    }
    __syncthreads();
}


namespace att {
typedef short v4i16 __attribute__((ext_vector_type(4)));
typedef float f32x2_t __attribute__((ext_vector_type(2)));
typedef __bf16 bf16x2_t __attribute__((ext_vector_type(2)));
constexpr float LOG2E = 1.4426950408889634f;
constexpr int VP = 288;
constexpr int LDS_K0 = 0, LDS_K1 = 26624, LDS_V0 = 53248, LDS_V1 = 71680, LDS_IMP = 90112  , LDS_TOT = 122880  , LDS_SEL = 131072  ,
              LDS_AUX = 131584  , LDS_QW = 132608  , LDS_GATE = 133120  ;
__device__ __forceinline__ unsigned cvtpk(float lo, float hi) { f32x2_t v = {lo, hi}; bf16x2_t b = __builtin_convertvector(v, bf16x2_t); return __builtin_bit_cast(unsigned, b); }
__device__ __forceinline__ float x16(float v, float& o) { const auto r = __builtin_amdgcn_permlane16_swap(__float_as_uint(v), __float_as_uint(v), false, false); o = __uint_as_float(r[1]); return __uint_as_float(r[0]); }
__device__ __forceinline__ float x32(float v, float& o) { const auto r = __builtin_amdgcn_permlane32_swap(__float_as_uint(v), __float_as_uint(v), false, false); o = __uint_as_float(r[1]); return __uint_as_float(r[0]); }
__device__ __forceinline__ float gmax(float v) { float o; float a = x16(v, o); v = fmaxf(a, o); a = x32(v, o); return fmaxf(a, o); }
__device__ __forceinline__ float gsum(float v) { float o; float a = x16(v, o); v = a + o; a = x32(v, o); return a + o; }
template <int DKT> __device__ __forceinline__ int koff(int row, int ch) { return row * (DKT * 2 + 32) + (ch << 4); }
__device__ __forceinline__ int voff(int row, int ch) { return row * VP + (ch << 4); }

template <int DKT, int MODE> struct Stage {
    static constexpr int KCH = DKT / 8, NKP = DKT / 64;
    u32x4 k[NKP]; u32x4 v[2]; f32x4 aux;
    __device__ __forceinline__ void load(const bf16* Kg, int kpitch, const bf16* Vg, int vpitch, const float* cf, const float* rk, int j, int tid) {
        const int row = tid >> 3, c8 = tid & 7;
        const char* kt = (const char*)(Kg + (size_t)(64 * j) * kpitch); const unsigned ko = (unsigned)(row * kpitch + c8 * 8) * 2u;
        const char* vt = (const char*)(Vg + (size_t)(64 * j) * vpitch); const unsigned vo = (unsigned)(row * vpitch + c8 * 8) * 2u;
#pragma unroll
        for (int i = 0; i < NKP; ++i) k[i] = *(const u32x4*)(kt + ko + 128 * i);
#pragma unroll
        for (int i = 0; i < 2; ++i) v[i] = *(const u32x4*)(vt + vo + 128 * i);
        if (MODE != 1) { if (tid < 32) { const float* src = (MODE == 0 && tid < 16) ? cf : rk; aux = *(const f32x4*)(src + 64 * j + 4 * (tid & 15)); } }
    }
    __device__ __forceinline__ void store(LAS unsigned char* Kb, LAS unsigned char* Vb, LAS float* auxb, float cref, int tid) const {
        const int row = tid >> 3, c8 = tid & 7;
#pragma unroll
        for (int i = 0; i < NKP; ++i) *(LAS u32x4*)(Kb + koff<DKT>(row, c8 + 8 * i)) = k[i];
#pragma unroll
        for (int i = 0; i < 2; ++i) *(LAS u32x4*)(Vb + voff(row, c8 + 8 * i)) = v[i];
        if (MODE != 1) { if (tid < 32) { f32x4 o;
            if (MODE == 0 && tid < 16) o = (cref - aux) * LOG2E;
            else { const f32x4 sq = aux * (1.0f / DKT) + EPS; o = (f32x4){__builtin_amdgcn_rsqf(sq[0]), __builtin_amdgcn_rsqf(sq[1]), __builtin_amdgcn_rsqf(sq[2]), __builtin_amdgcn_rsqf(sq[3])}; }
            *(LAS f32x4*)(auxb + ((MODE == 0 && tid < 16) ? 0 : 64) + 4 * (tid & 15)) = o; } }
    }
};

struct Ctx {
    float sl;
    const float* cf;
    const float* rk;
    float cref;
    float bt;
    int q0;
    int tq0;
    unsigned selm[2];
};

template <int DKT, int MODE> __device__ __forceinline__ void qk_half(f32x4 (&S)[2][2], const LAS unsigned char* Kb, const LAS float* auxb, const bf16x8 (&Q)[2][DKT / 32], const Ctx& c, int j, int hf, bool need_mask, int lane) {
    const int i16 = lane & 15, g = lane >> 4;
    const int kbase = i16 * (DKT * 2 + 32) + g * 16;
#pragma unroll
    for (int k2 = 0; k2 < 2; ++k2) {
        if (MODE == 1) { const int kl0 = 64 * j + 16 * (2 * hf + k2) + 4 * g; const float b0 = c.sl * (float)(16 * kl0 + 31 - c.q0);
            const f32x4 bias = (f32x4){b0, b0 + 16.f * c.sl, b0 + 32.f * c.sl, b0 + 48.f * c.sl}; S[0][k2] = bias; S[1][k2] = bias; }
        else { S[0][k2] = (f32x4){0.f, 0.f, 0.f, 0.f}; S[1][k2] = (f32x4){0.f, 0.f, 0.f, 0.f}; }
    }
    {
        bf16x8 ka[2], kb[2];
#define ATT_LDK(dst, ks_) do { _Pragma("unroll") for (int k2 = 0; k2 < 2; ++k2) dst[k2] = *(const LAS bf16x8*)(Kb + kbase + ((2 * hf + k2) * 16 * (DKT * 2 + 32) + (ks_) * 64)); } while (0)
#define ATT_MMK(src, ks_) do { _Pragma("unroll") for (int k2 = 0; k2 < 2; ++k2) { \
        S[0][k2] = __builtin_amdgcn_mfma_f32_16x16x32_bf16(src[k2], Q[0][ks_], S[0][k2], 0, 0, 0); \
        S[1][k2] = __builtin_amdgcn_mfma_f32_16x16x32_bf16(src[k2], Q[1][ks_], S[1][k2], 0, 0, 0); } } while (0)
        ATT_LDK(ka, 0);
#pragma unroll
        for (int ks = 0; ks < DKT / 32; ks += 2) {
            ATT_LDK(kb, ks + 1);
            ATT_MMK(ka, ks);
            if (ks + 2 < DKT / 32) ATT_LDK(ka, ks + 2);
            ATT_MMK(kb, ks + 1);
        }
#undef ATT_LDK
#undef ATT_MMK
    }
    if (MODE != 1) {
#pragma unroll
        for (int k2 = 0; k2 < 2; ++k2) {
            const int kq = 16 * (2 * hf + k2) + 4 * g;
            const f32x4 rs = *(const LAS f32x4*)(auxb + 64 + kq);
            f32x4 bias;
            if (MODE == 0) bias = *(const LAS f32x4*)(auxb + kq);
            else { const float b0 = c.sl * (float)(64 * j + kq - c.q0); bias = (f32x4){b0, b0 + c.sl, b0 + 2.f * c.sl, b0 + 3.f * c.sl}; }
#pragma unroll
            for (int e = 0; e < 4; ++e) { float t0 = __builtin_fmaf(S[0][k2][e], rs[e], bias[e]), t1 = __builtin_fmaf(S[1][k2][e], rs[e], bias[e]);
                                          asm("" : "+v"(t0)); asm("" : "+v"(t1)); S[0][k2][e] = t0; S[1][k2][e] = t1; }
        }
    }
    if (need_mask) {
#pragma unroll
        for (int qg = 0; qg < 2; ++qg)
#pragma unroll
            for (int k2 = 0; k2 < 2; ++k2)
#pragma unroll
                for (int r = 0; r < 4; ++r) {
                    const int kl = 64 * j + 16 * (2 * hf + k2) + 4 * g + r; bool ok;
                    if (MODE == 0) ok = kl <= (c.tq0 + 16 * qg);
                    else if (MODE == 1) ok = 16 * kl + 31 <= (c.tq0 + 16 * qg);
                    else if (MODE == 2) ok = (kl <= (c.tq0 + 16 * qg)) && ((c.selm[qg] >> j) & 1u);
                    else ok = (kl <= (c.tq0 + 16 * qg)) && ((c.tq0 + 16 * qg) - kl < 512);
                    if (!ok) S[qg][k2][r] = -INFINITY;
                }
    }
}

__device__ __forceinline__ void softmax_pv_half(f32x4 (&S)[2][2], const LAS unsigned char* Vb, int hf, f32x4 (&O)[2][8], float (&m)[2], float (&l)[2], int lane) {
    const int i16 = lane & 15, g = lane >> 4;
    bf16x8 P[2];
#pragma unroll
    for (int qg = 0; qg < 2; ++qg) {
        float tm = fmaxf(fmaxf(fmaxf(S[qg][0][0], S[qg][0][1]), fmaxf(S[qg][0][2], S[qg][0][3])), fmaxf(fmaxf(S[qg][1][0], S[qg][1][1]), fmaxf(S[qg][1][2], S[qg][1][3])));
        tm = gmax(tm);
        const float mn = fmaxf(m[qg], tm), mr = (mn == -INFINITY) ? 0.f : mn;
        const float alpha = __builtin_amdgcn_exp2f(m[qg] - mr); m[qg] = mn;
        float ls = 0.f;
#pragma unroll
        for (int k2 = 0; k2 < 2; ++k2)
#pragma unroll
            for (int r = 0; r < 4; ++r) { const float pv = __builtin_amdgcn_exp2f(S[qg][k2][r] - mr); S[qg][k2][r] = pv; ls += pv; }
        l[qg] = l[qg] * alpha + ls;
        if (__any(alpha < 1.f)) {
#pragma unroll
            for (int db = 0; db < 8; ++db) O[qg][db] *= alpha;
        }
        u32x4 w; w.x = cvtpk(S[qg][0][0], S[qg][0][1]); w.y = cvtpk(S[qg][0][2], S[qg][0][3]); w.z = cvtpk(S[qg][1][0], S[qg][1][1]); w.w = cvtpk(S[qg][1][2], S[qg][1][3]);
        P[qg] = __builtin_bit_cast(bf16x8, w);
    }
    const int q4 = i16 >> 2, p4 = i16 & 3;
    const int vbase = (4 * g + q4) * VP + (p4 >> 1) * 16 + (p4 & 1) * 8;
    {
        v4i16 a0[2], b0[2], a1[2], b1[2];
#define ATT_LDV(A, B, gi) do { _Pragma("unroll") for (int e = 0; e < 2; ++e) { const int db = 2 * (gi) + e; \
        A[e] = __builtin_amdgcn_ds_read_tr16_b64_v4i16((LAS v4i16*)(Vb + vbase + (hf * 32 * VP + db * 32))); \
        B[e] = __builtin_amdgcn_ds_read_tr16_b64_v4i16((LAS v4i16*)(Vb + vbase + (hf * 32 * VP + 16 * VP + db * 32))); } } while (0)
#define ATT_MMV(A, B, gi) do { _Pragma("unroll") for (int e = 0; e < 2; ++e) { const int db = 2 * (gi) + e; \
        const bf16x8 vf = (bf16x8){A[e][0], A[e][1], A[e][2], A[e][3], B[e][0], B[e][1], B[e][2], B[e][3]}; \
        O[0][db] = __builtin_amdgcn_mfma_f32_16x16x32_bf16(vf, P[0], O[0][db], 0, 0, 0); \
        O[1][db] = __builtin_amdgcn_mfma_f32_16x16x32_bf16(vf, P[1], O[1][db], 0, 0, 0); } } while (0)
        ATT_LDV(a0, b0, 0);
        ATT_LDV(a1, b1, 1); ATT_MMV(a0, b0, 0);
        ATT_LDV(a0, b0, 2); ATT_MMV(a1, b1, 1);
        ATT_LDV(a1, b1, 3); ATT_MMV(a0, b0, 2);
        ATT_MMV(a1, b1, 3);
#undef ATT_LDV
#undef ATT_MMV
    }
}

__device__ __forceinline__ void softmax_pv_full(f32x4 (&S)[2][2], f32x4 (&S1)[2][2], const LAS unsigned char* Vb, f32x4 (&O)[2][8], float (&m)[2], float (&l)[2], int lane) {
    const int i16 = lane & 15, g = lane >> 4;
    bf16x8 P[2][2];
    float tmv[2];
#pragma unroll
    for (int qg = 0; qg < 2; ++qg) {
        const float tm0 = fmaxf(fmaxf(fmaxf(S[qg][0][0], S[qg][0][1]), fmaxf(S[qg][0][2], S[qg][0][3])), fmaxf(fmaxf(S[qg][1][0], S[qg][1][1]), fmaxf(S[qg][1][2], S[qg][1][3])));
        const float tm1 = fmaxf(fmaxf(fmaxf(S1[qg][0][0], S1[qg][0][1]), fmaxf(S1[qg][0][2], S1[qg][0][3])), fmaxf(fmaxf(S1[qg][1][0], S1[qg][1][1]), fmaxf(S1[qg][1][2], S1[qg][1][3])));
        tmv[qg] = gmax(fmaxf(tm0, tm1));
    }
    if (!__any(tmv[0] + 40.f > m[0] || tmv[1] + 40.f > m[1])) return;
#pragma unroll
    for (int qg = 0; qg < 2; ++qg) {
        const float tm = tmv[qg];
        const float mn = fmaxf(m[qg], tm), mr = (mn == -INFINITY) ? 0.f : mn;
        const float alpha = __builtin_amdgcn_exp2f(m[qg] - mr); m[qg] = mn;
        float ls = 0.f, ls1 = 0.f;
#pragma unroll
        for (int k2 = 0; k2 < 2; ++k2)
#pragma unroll
            for (int r = 0; r < 4; ++r) { const float pv = __builtin_amdgcn_exp2f(S[qg][k2][r] - mr); S[qg][k2][r] = pv; ls += pv;
                                          const float pw = __builtin_amdgcn_exp2f(S1[qg][k2][r] - mr); S1[qg][k2][r] = pw; ls1 += pw; }
        l[qg] = l[qg] * alpha + (ls + ls1);
        if (__any(alpha < 1.f)) {
#pragma unroll
            for (int db = 0; db < 8; ++db) O[qg][db] *= alpha;
        }
        u32x4 w; w.x = cvtpk(S[qg][0][0], S[qg][0][1]); w.y = cvtpk(S[qg][0][2], S[qg][0][3]); w.z = cvtpk(S[qg][1][0], S[qg][1][1]); w.w = cvtpk(S[qg][1][2], S[qg][1][3]);
        P[0][qg] = __builtin_bit_cast(bf16x8, w);
        w.x = cvtpk(S1[qg][0][0], S1[qg][0][1]); w.y = cvtpk(S1[qg][0][2], S1[qg][0][3]); w.z = cvtpk(S1[qg][1][0], S1[qg][1][1]); w.w = cvtpk(S1[qg][1][2], S1[qg][1][3]);
        P[1][qg] = __builtin_bit_cast(bf16x8, w);
    }
    const int q4 = i16 >> 2, p4 = i16 & 3;
    const int vbase = (4 * g + q4) * VP + (p4 >> 1) * 16 + (p4 & 1) * 8;
    {
        v4i16 a0[2], b0[2], a1[2], b1[2];
#define ATT_LDV(A, B, gi) do { _Pragma("unroll") for (int e = 0; e < 2; ++e) { const int db = 2 * ((gi) & 3) + e, hf = (gi) >> 2; \
        A[e] = __builtin_amdgcn_ds_read_tr16_b64_v4i16((LAS v4i16*)(Vb + vbase + (hf * 32 * VP + db * 32))); \
        B[e] = __builtin_amdgcn_ds_read_tr16_b64_v4i16((LAS v4i16*)(Vb + vbase + (hf * 32 * VP + 16 * VP + db * 32))); } } while (0)
#define ATT_MMV(A, B, gi) do { _Pragma("unroll") for (int e = 0; e < 2; ++e) { const int db = 2 * ((gi) & 3) + e, hf = (gi) >> 2; \
        const bf16x8 vf = (bf16x8){A[e][0], A[e][1], A[e][2], A[e][3], B[e][0], B[e][1], B[e][2], B[e][3]}; \
        O[0][db] = __builtin_amdgcn_mfma_f32_16x16x32_bf16(vf, P[hf][0], O[0][db], 0, 0, 0); \
        O[1][db] = __builtin_amdgcn_mfma_f32_16x16x32_bf16(vf, P[hf][1], O[1][db], 0, 0, 0); } } while (0)
        ATT_LDV(a0, b0, 0);
        ATT_LDV(a1, b1, 1); ATT_MMV(a0, b0, 0);
        ATT_LDV(a0, b0, 2); ATT_MMV(a1, b1, 1);
        ATT_LDV(a1, b1, 3); ATT_MMV(a0, b0, 2);
        ATT_LDV(a0, b0, 4); ATT_MMV(a1, b1, 3);
        ATT_LDV(a1, b1, 5); ATT_MMV(a0, b0, 4);
        ATT_LDV(a0, b0, 6); ATT_MMV(a1, b1, 5);
        ATT_LDV(a1, b1, 7); ATT_MMV(a0, b0, 6);
        ATT_MMV(a1, b1, 7);
#undef ATT_LDV
#undef ATT_MMV
    }
}

template <int DKT, int MODE> __device__ __forceinline__ void branch(LAS unsigned char* lds, unsigned tiles, unsigned mskb, unsigned skipb, const bf16* Kg, int kpitch, const bf16* Vg, int vpitch,
                                                                    const bf16x8 (&Q)[2][DKT / 32], f32x4 (&O)[2][8], float (&m)[2], float (&l)[2], const Ctx& c, int tid, int lane,
                                                                    Stage<DKT, MODE>& st, bool preloaded  ) {
    LAS float* AUX = (LAS float*)(lds + LDS_AUX);
    int j = 31 - __builtin_clz(tiles), ib = 0;
    asm volatile("" : "+v"(tid), "+v"(lane));
    if (!preloaded) st.load(Kg, kpitch, Vg, vpitch, c.cf, c.rk, j, tid);
    st.store(lds + LDS_K0, lds + LDS_V0, AUX, c.cref, tid);
    tiles &= ~(1u << j);
    int nj = tiles ? 31 - __builtin_clz(tiles) : -1;
    if (nj >= 0) st.load(Kg, kpitch, Vg, vpitch, c.cf, c.rk, nj, tid);
    __syncthreads();
    for (;;) {
        asm volatile("" : "+v"(tid), "+v"(lane));
        const LAS unsigned char* Kb = lds + (ib ? LDS_K1 : LDS_K0); const LAS unsigned char* Vb = lds + (ib ? LDS_V1 : LDS_V0); const LAS float* auxb = AUX + (ib ? 128 : 0);
        bool skip = (skipb >> j) & 1u; const bool nm = (mskb >> j) & 1u;
        if (MODE != 1 && !skip) {
            const float bmax = (MODE == 0) ? auxb[63] : c.sl * (float)(64 * j + 63 - c.q0);
            skip = !__any(bmax + c.bt > fminf(m[0], m[1]));
        }
        f32x4 S[2][2], S1[2][2];
        if (!skip) {
            qk_half<DKT, MODE>(S, Kb, auxb, Q, c, j, 0, nm, lane); qk_half<DKT, MODE>(S1, Kb, auxb, Q, c, j, 1, nm, lane);
        }
        int nn = -1;
        if (nj >= 0) { st.store(lds + (ib ? LDS_K0 : LDS_K1), lds + (ib ? LDS_V0 : LDS_V1), AUX + (ib ? 0 : 128), c.cref, tid);
            tiles &= ~(1u << nj); nn = tiles ? 31 - __builtin_clz(tiles) : -1;
            if (nn >= 0) st.load(Kg, kpitch, Vg, vpitch, c.cf, c.rk, nn, tid); }
        if (!skip) softmax_pv_full(S, S1, Vb, O, m, l, lane);
        __syncthreads();
        if (nj < 0) break;
        ib ^= 1; j = nj; nj = nn;
    }
}

template <int DKT> __device__ __forceinline__ void load_q(bf16x8 (&Q)[2][DKT / 32], const bf16* qrow0  , size_t qg_stride, const float* gain, const float* gain2, float scale, int lane) {
    const int g = lane >> 4;
#pragma unroll
    for (int qg = 0; qg < 2; ++qg) {
        u32x4 raw[DKT / 32]; float ss = 0.f;
#pragma unroll
        for (int ks = 0; ks < DKT / 32; ++ks) { raw[ks] = *(const u32x4*)(qrow0 + qg * qg_stride + 32 * ks + 8 * g);
#pragma unroll
            for (int e = 0; e < 4; ++e) { const float a = __uint_as_float(raw[ks][e] << 16), b = __uint_as_float(raw[ks][e] & 0xffff0000u); ss += a * a + b * b; } }
        ss = gsum(ss);
        const float r = scale / sqrtf(ss * (1.0f / DKT) + EPS);
#pragma unroll
        for (int ks = 0; ks < DKT / 32; ++ks) asm volatile("" : "+v"(raw[ks]));
#pragma unroll
        for (int ks = 0; ks < DKT / 32; ++ks) { f32x4 g0 = *(const f32x4*)(gain + 32 * ks + 8 * g), g1 = *(const f32x4*)(gain + 32 * ks + 8 * g + 4); u32x4 w;
            if (gain2) { g0 *= *(const f32x4*)(gain2 + 32 * ks + 8 * g); g1 *= *(const f32x4*)(gain2 + 32 * ks + 8 * g + 4); }
#pragma unroll
            for (int e = 0; e < 4; ++e) { const float a = __uint_as_float(raw[ks][e] << 16), b = __uint_as_float(raw[ks][e] & 0xffff0000u);
                const float ga = e < 2 ? g0[2 * e] : g1[2 * e - 4], gb = e < 2 ? g0[2 * e + 1] : g1[2 * e - 3]; w[e] = cvtpk(a * r * ga, b * r * gb); }
            Q[qg][ks] = __builtin_bit_cast(bf16x8, w); }
    }
}

__device__ __forceinline__ void fox_unit(const Params& p, LAS unsigned char* lds, int b, int h, int qb, int tid, int wave, int lane, unsigned* qctr, volatile LAS unsigned* qslot) {
    unsigned char* ws = p.ws;
    asm volatile("" : "+v"(tid), "+v"(lane));
    const int i16 = lane & 15, g = lane >> 4, q0 = 256 * qb;
    const size_t rowb = (size_t)b * SEQ;
    bf16x8 Q[2][4];
    load_q<128>(Q, (const bf16*)(ws + WS_FQ) + (rowb + q0 + 32 * wave + i16) * 1024 + h * 128, (size_t)16 * 1024, p.in[I_FOX_Q_GAIN], p.in[I_FOX_K_GAIN], 0.08838834764831845f * LOG2E, lane);
    Ctx c; c.sl = 0.f; c.cf = (const float*)(ws + WS_CF) + ((size_t)b * FH + h) * SEQ; c.cref = c.cf[q0]; c.q0 = q0; c.bt = ((const float*)(ws + WS_THR))[3];
    c.rk = (const float*)(ws + WS_SSQ) + (size_t)h * MTOK + rowb;
    c.tq0 = q0 + 32 * wave + i16; c.selm[0] = 0u; c.selm[1] = 0u;
    f32x4 O[2][8]; float m[2] = {-INFINITY, -INFINITY}, l[2] = {0.f, 0.f};
#pragma unroll
    for (int qg = 0; qg < 2; ++qg)
#pragma unroll
        for (int db = 0; db < 8; ++db) O[qg][db] = (f32x4){0.f, 0.f, 0.f, 0.f};
    const unsigned nt = 4 * qb + 4; unsigned tiles = nt >= 32 ? 0xffffffffu : ((1u << nt) - 1u);
    {
        int ln = lane; asm volatile("" : "+v"(ln));
        const float thr = ((const float*)(ws + WS_THR))[0];
        const float cfj = c.cf[64 * (ln & 31) + 63];
        const bool far = ln < (int)nt && ln < 32 && (cfj - c.cref) * LOG2E >= thr;
        tiles &= ~(unsigned)__ballot(far);
    }
    const int qw = q0 + 32 * wave; const int jfull = (qw + 1) >> 6  , jvis = ((qw + 31) >> 6) + 1  ;
    const unsigned mskb = ~(jfull >= 32 ? 0xffffffffu : ((1u << jfull) - 1u)), skipb = jvis >= 32 ? 0u : ~((1u << jvis) - 1u);
    { Stage<128, 0> st0; branch<128, 0>(lds, tiles, mskb, skipb, (const bf16*)(ws + WS_FK) + rowb * 1024 + h * 128, 1024, (const bf16*)(ws + WS_FV) + rowb * 1024 + h * 128, 1024, Q, O, m, l, c, tid, lane, st0, false); }
    unsigned nxt = 0u;
    { int t0 = tid; asm volatile("" : "+v"(t0)); if (t0 == 0) nxt = gridDim.x + __hip_atomic_fetch_add(qctr, 1u, __ATOMIC_RELAXED, __HIP_MEMORY_SCOPE_AGENT); }
#pragma unroll
    for (int qg = 0; qg < 2; ++qg) {
        const float lt = gsum(l[qg]);
        const float inv = 1.0f / lt;
        bf16* orow = (bf16*)(ws + WS_OAB) + (rowb + (c.tq0 + 16 * qg)) * 2048 + h * 128 + 4 * g;
#pragma unroll
        for (int db = 0; db < 8; ++db) { const f32x4 o = O[qg][db] * inv; *(u32x2*)(orow + 16 * db) = (u32x2){cvtpk(o[0], o[1]), cvtpk(o[2], o[3])}; }
    }
    { int t0 = tid; asm volatile("" : "+v"(t0)); if (t0 == 0) qslot[0] = nxt; }
}

__device__ __forceinline__ float ulo(unsigned w) { return __uint_as_float(w << 16); }
__device__ __forceinline__ float uhi(unsigned w) { return __uint_as_float(w & 0xffff0000u); }

__device__ __forceinline__ unsigned nsa_far(float thr, float sl, int tw) {
    const float jm = floorf(((float)(tw - 63) - 1.001f * thr / sl) * (1.0f / 64.0f));
    const int j = jm < -1.f ? -1 : (jm > 31.f ? 31 : (int)jm);
    return j < 0 ? 0u : (j >= 31 ? 0xffffffffu : ((2u << j) - 1u));
}
__device__ __forceinline__ void nsa_unit(const Params& p, LAS unsigned char* lds, int b, int gq, int cur, int tid, int wave, int lane, unsigned* qctr, volatile LAS unsigned* qslot) {
    unsigned char* ws = p.ws;
    asm volatile("" : "+v"(tid), "+v"(lane));
    const int i16 = lane & 15, g = lane >> 4, q0 = 64 * cur, hh = wave >> 1, h = gq * HPG + hh, rbase = 32 * (wave & 1);
    const size_t rowb = (size_t)b * SEQ;
    bf16x8 Q[2][6];
#define ATT_LOADQ(g2) do { int ln_ = lane; asm volatile("" : "+v"(ln_)); \
        load_q<192>(Q, (const bf16*)(ws + WS_NQ) + (rowb + q0 + rbase + (ln_ & 15)) * 1536 + h * 192, (size_t)16 * 1536, p.in[I_NSA_Q_GAIN], (g2), 0.07216878364870322f * LOG2E, ln_); } while (0)
    const bf16* KCC = (const bf16*)(ws + WS_KCC) + (size_t)((b * 2 + gq) * 128) * 192; const bf16* VCC = (const bf16*)(ws + WS_VCC) + (size_t)((b * 2 + gq) * 128) * 128;
    const unsigned ctiles = cur >= 16 ? 3u : 1u;
    Stage<192, 1> stc; stc.load(KCC, 192, VCC, 128, nullptr, nullptr, (ctiles & 2u) ? 1 : 0, tid);
    ATT_LOADQ(nullptr);
    Ctx c; c.sl = exp2f(-(float)(h + 1)) * LOG2E; c.cf = nullptr; c.rk = nullptr; c.cref = 0.f; c.q0 = q0; c.bt = 0.f;
    c.tq0 = q0 + rbase + i16; c.selm[0] = 0u; c.selm[1] = 0u;
    LAS float* IMP = (LAS float*)(lds + LDS_IMP); LAS float* TOT = (LAS float*)(lds + LDS_TOT); LAS unsigned* SEL = (LAS unsigned*)(lds + LDS_SEL);
    if (tid < 64) SEL[tid] = 0u;
    LAS float* GLG = (LAS float*)(lds + LDS_GATE) + wave * 128;
    { int ln_ = lane; asm volatile("" : "+v"(ln_));
      if (ln_ < 32) { const float* gp = (const float*)(ws + WS_SMALL) + (rowb + q0 + rbase + ln_) * 32 + 8 + h * 3; GLG[ln_ * 4 + 0] = gp[0]; GLG[ln_ * 4 + 1] = gp[1]; GLG[ln_ * 4 + 2] = gp[2]; } }
    f32x4 O[2][8]; float m[2], l[2];
#define ATT_RESET() do { _Pragma("unroll") for (int qg = 0; qg < 2; ++qg) { m[qg] = -INFINITY; l[qg] = 0.f; _Pragma("unroll") for (int db = 0; db < 8; ++db) O[qg][db] = (f32x4){0.f, 0.f, 0.f, 0.f}; } } while (0)
#define ATT_FOLD(br, first) do { int ln_ = lane; asm volatile("" : "+v"(ln_));        \
    _Pragma("unroll") for (int qg = 0; qg < 2; ++qg) { const float lt = gsum(l[qg]); \
        const size_t row_ = rowb + q0 + rbase + 16 * qg + (ln_ & 15); \
        const float gl_ = GLG[(16 * qg + (ln_ & 15)) * 4 + (br)]; \
        const float wgt = lt > 0.f ? 1.f / ((1.f + __expf(-gl_)) * lt) : 0.f; \
        bf16* orow = (bf16*)(ws + WS_OAB) + row_ * 2048 + 1024 + h * 128 + 4 * (ln_ >> 4); \
        _Pragma("unroll") for (int db = 0; db < 8; ++db) { f32x4 o = O[qg][db] * wgt; \
            if (!(first)) { const u32x2 pv = *(const u32x2*)(orow + 16 * db); o[0] += ulo(pv.x); o[1] += uhi(pv.x); o[2] += ulo(pv.y); o[3] += uhi(pv.y); } \
            *(u32x2*)(orow + 16 * db) = (u32x2){cvtpk(o[0], o[1]), cvtpk(o[2], o[3])}; } } } while (0)
    ATT_RESET();
    branch<192, 1>(lds, ctiles, 3u, 0u, KCC, 192, VCC, 128, Q, O, m, l, c, tid, lane, stc, true);
    ATT_FOLD(0, true);
    Stage<192, 2> sts;
    c.rk = (const float*)(ws + WS_SSQ) + (size_t)(8 + gq) * MTOK + rowb; c.bt = ((const float*)(ws + WS_THR))[4];
    sts.load((const bf16*)(ws + WS_KS) + rowb * 384 + gq * 192, 384, (const bf16*)(ws + WS_VS) + rowb * 256 + gq * 128, 256, nullptr, c.rk, cur, tid);
    {
        float invl[2], mr[2];
#pragma unroll
        for (int qg = 0; qg < 2; ++qg) { const float lt = gsum(l[qg]); invl[qg] = lt > 0.f ? 1.f / lt : 0.f; mr[qg] = (m[qg] == -INFINITY) ? 0.f : m[qg]; }
        float carry[2] = {0.f, 0.f};
        int ln2 = lane; asm volatile("" : "+v"(ln2));
        LAS float* improw = IMP + ((hh * 64) + rbase + (ln2 & 15)) * 32 + (ln2 >> 4);
#pragma unroll
        for (int tt = 0; tt < 2; ++tt)
#pragma unroll
            for (int hf = 0; hf < 2; ++hf) {
                f32x4 S[2][2];
                if (tt == 0 || (ctiles & 2u)) qk_half<192, 1>(S, lds + (((ctiles & 2u) ? (tt == 0) : false) ? LDS_K1 : LDS_K0), nullptr, Q, c, tt, hf, true, lane);
                else {
#pragma unroll
                    for (int qg = 0; qg < 2; ++qg)
#pragma unroll
                        for (int k2 = 0; k2 < 2; ++k2) S[qg][k2] = (f32x4){-INFINITY, -INFINITY, -INFINITY, -INFINITY};
                }
#pragma unroll
                for (int qg = 0; qg < 2; ++qg) {
                    float xprev = carry[qg];
#pragma unroll
                    for (int k2 = 0; k2 < 2; ++k2) {
                        float pr[4];
#pragma unroll
                        for (int r = 0; r < 4; ++r) pr[r] = __builtin_amdgcn_exp2f(S[qg][k2][r] - mr[qg]) * invl[qg];
                        const float up = __shfl(pr[3], (lane + 48) & 63);
                        const float wrap = __shfl(xprev, (lane + 48) & 63);
                        const float prev = g == 0 ? wrap : up;
                        improw[16 * qg * 32 + 16 * tt + 4 * (2 * hf + k2)] = 2.f * (pr[0] + pr[1] + pr[2]) + pr[3] + prev;
                        xprev = pr[3];
                    }
                    carry[qg] = xprev;
                }
            }
    }
    __syncthreads();
    {
        int tid2 = tid; asm volatile("" : "+v"(tid2));
        const int t = tid2 >> 3, jq = tid2 & 7;
#pragma unroll
        for (int e = 0; e < 4; ++e) { const int j = 4 * jq + e;
            const float im = (IMP[(0 * 64 + t) * 32 + j] + IMP[(1 * 64 + t) * 32 + j]) + (IMP[(2 * 64 + t) * 32 + j] + IMP[(3 * 64 + t) * 32 + j]);
            const bool elig = j <= cur, forced = (j == 0) || (elig && (cur - j) < 2);
            TOT[t * 32 + j] = elig ? (forced ? 1.0e4f : im) : -1.f; }
        __syncthreads();
        unsigned bits = 0u;
#pragma unroll
        for (int e = 0; e < 4; ++e) { const int j = 4 * jq + e; const float sj = TOT[t * 32 + j]; int rank = 0;
#pragma unroll 4
            for (int j2 = 0; j2 < 32; ++j2) { const float s2 = TOT[t * 32 + j2]; rank += (s2 > sj || (s2 == sj && j2 < j)) ? 1 : 0; }
            if (rank < 16 && sj >= 0.f) bits |= 1u << j; }
        if (bits) atomicOr((unsigned*)(SEL + t), bits);
        __syncthreads();
    }
    c.selm[0] = SEL[rbase + i16]; c.selm[1] = SEL[rbase + 16 + i16];
    unsigned U = SEL[lane];
#pragma unroll
    for (int o = 32; o > 0; o >>= 1) U |= __shfl_xor(U, o);
    U = __builtin_amdgcn_readfirstlane(U);
    ATT_RESET();
    { unsigned wand = c.selm[0] & c.selm[1], wor = c.selm[0] | c.selm[1];
#pragma unroll
      for (int o = 1; o < 16; o <<= 1) { wand &= __shfl_xor(wand, o); wor |= __shfl_xor(wor, o); }
      wand = __builtin_amdgcn_readfirstlane(wand); wor = __builtin_amdgcn_readfirstlane(wor);
      branch<192, 2>(lds, U, ~wand | (1u << cur), ~wor | nsa_far(((const float*)(ws + WS_THR))[1], c.sl, q0 + rbase), (const bf16*)(ws + WS_KS) + rowb * 384 + gq * 192, 384, (const bf16*)(ws + WS_VS) + rowb * 256 + gq * 128, 256, Q, O, m, l, c, tid, lane, sts, true); }
    Stage<192, 3> stw;
    c.rk = (const float*)(ws + WS_SSQ) + (size_t)(10 + gq) * MTOK + rowb; c.bt = ((const float*)(ws + WS_THR))[5];
    stw.load((const bf16*)(ws + WS_KW) + rowb * 384 + gq * 192, 384, (const bf16*)(ws + WS_VW) + rowb * 256 + gq * 128, 256, nullptr, c.rk, cur, tid);
    ATT_FOLD(1, false);
    ATT_RESET();
    { const int jlo = cur >= 8 ? cur - 8 : 0; const unsigned hi_m = cur >= 31 ? 0xffffffffu : ((1u << (cur + 1)) - 1u); const unsigned wt = hi_m & ~((1u << jlo) - 1u);
      branch<192, 3>(lds, wt, (1u << cur) | (cur >= 8 ? (1u << (cur - 8)) : 0u), nsa_far(((const float*)(ws + WS_THR))[2], c.sl, q0 + rbase), (const bf16*)(ws + WS_KW) + rowb * 384 + gq * 192, 384, (const bf16*)(ws + WS_VW) + rowb * 256 + gq * 128, 256, Q, O, m, l, c, tid, lane, stw, true); }
    unsigned nxt = 0u;
    { int t0 = tid; asm volatile("" : "+v"(t0)); if (t0 == 0) nxt = gridDim.x + __hip_atomic_fetch_add(qctr, 1u, __ATOMIC_RELAXED, __HIP_MEMORY_SCOPE_AGENT); }
    ATT_FOLD(2, false);
    { int t0 = tid; asm volatile("" : "+v"(t0)); if (t0 == 0) qslot[0] = nxt; }
#undef ATT_RESET
#undef ATT_FOLD
#undef ATT_LOADQ
    __syncthreads();
}

__device__ const unsigned short ATT_ORDER[884] = {276,277,278,279,280,281,282,283,284,285,286,287,308,309,310,311,312,313,314,315,316,317,318,319,340,341,342,343,344,345,346,347,348,349,350,351,372,373,374,375,376,377,378,379,380,381,382,383,404,405,406,407,408,409,410,411,412,413,414,415,436,437,438,439,440,441,442,443,444,445,446,447,468,469,470,471,472,473,474,475,476,477,478,479,500,501,502,503,504,505,506,507,508,509,510,511,275,307,339,371,403,435,467,499,274,306,338,370,402,434,466,498,273,305,337,369,401,433,465,497,272,304,336,368,400,432,464,496,271,303,335,367,399,431,463,495,270,302,334,366,398,430,462,494,269,301,333,365,397,429,461,493,268,300,332,364,396,428,460,492,267,299,331,363,395,427,459,491,266,298,330,362,394,426,458,490,265,297,329,361,393,425,457,489,264,296,328,360,392,424,456,488,263,295,327,359,391,423,455,487,262,294,326,358,390,422,454,486,7,15,23,31,39,47,55,63,71,79,87,95,103,111,119,127,135,143,151,159,167,175,183,191,199,207,215,223,231,239,247,255,261,293,325,357,389,421,453,485,6,14,22,30,38,46,54,62,70,78,86,94,102,110,118,126,134,142,150,158,166,174,182,190,198,206,214,222,230,238,246,254,260,292,324,356,388,420,452,484,259,291,323,355,387,419,451,483,5,13,21,29,37,45,53,61,69,620,77,85,621,93,622,101,623,109,624,117,625,125,626,133,627,141,628,149,629,157,165,630,173,631,181,632,189,633,197,634,205,635,213,636,221,637,229,638,237,245,639,253,640,258,641,290,642,322,643,354,644,386,645,418,646,450,647,482,4,648,12,649,20,650,28,651,36,652,44,653,52,654,60,655,68,656,76,84,657,92,658,100,659,108,660,116,661,124,662,132,663,140,664,148,665,156,164,666,172,667,180,668,188,669,196,670,204,671,212,672,220,673,228,674,236,244,675,252,676,257,677,289,678,321,679,353,680,385,681,417,682,449,683,481,256,684,288,685,320,686,352,687,384,688,416,689,448,690,480,691,3,692,11,19,693,27,694,35,695,43,696,51,697,59,698,67,699,75,700,83,701,91,99,702,107,703,115,704,123,705,131,706,139,707,147,708,155,709,163,710,171,179,711,187,712,195,713,203,714,211,715,219,716,227,717,235,718,243,719,251,512,720,513,721,514,722,515,723,516,724,517,725,518,726,519,727,520,728,521,522,729,523,730,524,731,525,732,526,733,527,734,528,735,529,736,530,737,531,532,738,533,739,534,740,535,741,536,742,537,743,538,744,539,745,540,746,541,542,747,543,748,544,749,545,750,546,751,547,752,548,753,549,754,550,755,551,552,756,553,757,554,758,555,759,556,760,557,761,558,762,559,763,560,764,561,562,765,563,766,564,767,565,768,566,769,567,770,568,771,569,772,570,773,571,572,774,573,775,574,776,575,777,2,778,10,779,18,780,26,781,34,782,42,50,783,58,784,66,785,74,786,82,787,90,788,98,789,106,790,114,791,122,130,792,138,793,146,794,154,795,162,796,170,797,178,798,186,799,194,800,202,210,801,218,802,226,803,234,804,242,805,250,806,1,807,9,808,17,809,25,33,810,41,811,49,812,57,813,65,814,73,815,81,816,89,817,97,818,105,113,819,121,820,129,821,137,822,145,823,153,824,161,825,169,826,177,827,185,193,828,201,829,209,830,217,831,225,832,233,833,241,834,249,835,0,836,8,16,837,24,838,32,839,40,840,48,841,56,842,64,843,72,844,80,845,88,96,846,104,847,112,848,120,849,128,850,136,851,144,852,152,853,160,854,168,176,855,184,856,192,857,200,858,208,859,216,860,224,861,232,862,240,863,248,864,865,866,867,868,869,870,871,872,873,874,875,876,877,878,879,880,881,882,883,884,885,886,887,888,889,890,891,892,893,894,895,896,897,898,899,900,901,902,903,904,905,906,907,908,909,910,911,912,913,914,915,916,917,918,919,920,921,922,923,924,925,926,927};

__device__ __forceinline__ void attn_phase(const Params& p, LAS unsigned char* lds, int vcu, int G, int tid, int wave, int lane) {
    unsigned* qctr = (unsigned*)(p.ws + WS_CTL) + 64;
    volatile LAS unsigned* qw = (volatile LAS unsigned*)(lds + LDS_QW);
    bool have = true;
    if (tid == 0) qw[0] = (unsigned)vcu;
    for (;;) {
        if (!have && tid == 0) qw[0] = (unsigned)G + __hip_atomic_fetch_add(qctr, 1u, __ATOMIC_RELAXED, __HIP_MEMORY_SCOPE_AGENT);
        __syncthreads();
        const unsigned slot = __builtin_amdgcn_readfirstlane(qw[0]);
        __syncthreads();
        if (slot >= 884u) break;
        const int id = ATT_ORDER[slot];
        have = id < 512 || id >= 576;
        if (id < 256) fox_unit(p, lds, id >> 6, (id >> 3) & 7, id & 7, tid, wave, lane, qctr, qw);
        else if (id < 512) { const int v = id - 256; nsa_unit(p, lds, v >> 6, (v >> 5) & 1, v & 31, tid, wave, lane, qctr, qw); }
        else if (id >= 576) {
            unsigned nxt = 0u;
            if (tid == 0) nxt = (unsigned)G + __hip_atomic_fetch_add(qctr, 1u, __ATOMIC_RELAXED, __HIP_MEMORY_SCOPE_AGENT);
            conv_chunk32(p, lds, 32 * (id - 576), wave, lane);
            if (tid == 0) qw[0] = nxt;
        }
        else {
            pg8::Gemm g{(const bf16*)(p.ws + WS_XN), (const bf16*)(p.ws + WS_WIN), 2048, 2048, 2048};
            pg8::Gemm1Order S; S.so.init(MTOK, 10240, G, 0); S.tail = 1; S.tc = id - 512; S.Gt = 64;
            EpiProj E{p.ws, p.in[I_NSA_KS_GAIN], p.in[I_NSA_KW_GAIN]};
            pg8::gemm_phase<EpiProj, pg8::Gemm1Order, true>(lds, g, S, E, wave);
            __syncthreads();
        }
    }
}
}

__global__ void __launch_bounds__(NTHREADS, 2) fwd(Params p) {
    extern __shared__ __attribute__((aligned(16))) unsigned char lds_raw[];
    LAS unsigned char* lds = (LAS unsigned char*)lds_raw;
    const int wave = __builtin_amdgcn_readfirstlane((int)threadIdx.x >> 6);
#define TID_ (wave * 64 + lane_id())
#define LANE_ (lane_id())
    const int G = gridDim.x, bx = blockIdx.x;
    const int vcu = (G % 8 == 0) ? (bx % 8) * (G / 8) + bx / 8 : bx;
    const int gw = vcu * NWAVES + wave, NGW = G * NWAVES;
    unsigned char* ws = p.ws;
    const int lo = p.ph_lo, hi = p.ph_hi;
#ifndef ONLY_PHASE
#define ONLY_PHASE -1
#endif
#define IN(k) ((ONLY_PHASE < 0 || ONLY_PHASE == (k)) && lo <= (k) && (k) < hi)
    cg::grid_group grid = cg::this_grid();
    volatile LAS unsigned* bst = (volatile LAS unsigned*)(lds + LDS_BYTES - 16);
    if (TID_ < 4) bst[TID_] = 0u;
    __syncthreads();
    XcdBarrier xbar = xcd_barrier_post((unsigned*)(ws + WS_CTL) + 4096, bst, wave);
    if (p.ph_lo < 0) grid.sync();
#define SEAM(k) do { if (IN(k) && IN((k) + 1)) xcd_barrier(xbar); } while (0)
    if (IN(PH_P0)) { phase_p0(p, lds, gw, NGW, wave, LANE_); }
    SEAM(PH_P0);
    if (IN(PH_GEMM1)) {
        pg8::Gemm g{(const bf16*)(ws + WS_XN), (const bf16*)(ws + WS_WIN), 2048, 2048, 2048};
        pg8::Gemm1Order S; S.so.init(MTOK, 10240, G, bx); S.tail = 0; S.tc = 0; S.Gt = 1;
        EpiProj E{ws, p.in[I_NSA_KS_GAIN], p.in[I_NSA_KW_GAIN]};
        pg8::gemm_phase<EpiProj, pg8::Gemm1Order, true>(lds, g, S, E, wave);
    }
    SEAM(PH_GEMM1);
    if (IN(PH_P2A)) {
        if (bx == (G == 256 ? 231 : 200 % G)) {
            const int t_ = TID_; const bool isv = t_ >= 256; const int n = t_ & 255, nbp = isv ? 64 : 96;
            const float* bp = (const float*)(ws + (isv ? WS_BPV : WS_BPK)); float s0 = 0.f, s1 = 0.f, s2 = 0.f, s3 = 0.f;
            for (int i = 0; i < nbp; i += 16) { float t[16];
#pragma unroll
                for (int e = 0; e < 16; ++e) t[e] = bp[(i + e) * 256 + n];
#pragma unroll
                for (int e = 0; e < 16; e += 4) { s0 += t[e]; s1 += t[e + 1]; s2 += t[e + 2]; s3 += t[e + 3]; } }
            ((float*)(ws + WS_BIAS))[(isv ? 256 : 0) + n] = (s0 + s1) + (s2 + s3);
        }
        if (G == 256) { if (bx >= 48 && bx < 80 && wave == 0) phase_cumsum(p, bx - 48, 32, LANE_); }
        else phase_cumsum(p, (G - 1 - vcu) * NWAVES + wave, NGW, LANE_);
        if (G == 256) {
            if ((bx >= 48 && bx < 128) || bx >= 160) { const int ci = (bx < 128 ? bx - 48 : bx - 80) * NWAVES + wave;
                phase_mix_weights(p, lds, ci, 176 * NWAVES, wave, LANE_);
                phase_ffn_weights<true>(p, lds, ci, 176 * NWAVES, wave, LANE_, 0, 1408); }
        } else { phase_mix_weights(p, lds, gw, NGW, wave, LANE_); phase_ffn_weights(p, lds, gw, NGW, wave, LANE_, 11264, 11264 + 5632); }

        __syncthreads();
        { pg8::Gemm g{(const bf16*)(ws + WS_KC), (const bf16*)(ws + WS_CW1K), 3072, 6144, KSLICE}; pg8::SplitOrder S{4, KS_K, G, bx};
          EpiSlab E{(float*)(ws + WS_HSLK)}; pg8::gemm_phase<EpiSlab, pg8::SplitOrder, false>(lds, g, S, E, wave); }
        { pg8::Gemm g{(const bf16*)(ws + WS_VC), (const bf16*)(ws + WS_CW1V), 2048, 4096, KSLICE}; pg8::SplitOrder S{4, KS_V, G, (bx + G / 2) % G};
          EpiSlab E{(float*)(ws + WS_HSLV)}; pg8::gemm_phase<EpiSlab, pg8::SplitOrder, false>(lds, g, S, E, wave); }

    }
    SEAM(PH_P2A);
    if (IN(PH_P2B)) {
        for (int u = bx; u < 256; u += G) cmp_finish_unit(p, lds, u, TID_);
    }
    SEAM(PH_P2B);
    if (IN(PH_ATTN)) { __syncthreads(); att::attn_phase(p, lds, vcu, G, TID_, wave, LANE_); }
    SEAM(PH_ATTN);
    if (IN(PH_MERGE)) {
        pg8::Gemm g{(const bf16*)(ws + WS_OAB), (const bf16*)(ws + WS_WU), 2048, 2048, 2048};
        pg8::StaticOrder S; S.init(MTOK, 2048, G, bx);
        EpiMerge E{(const bf16*)(ws + WS_GA), (const bf16*)(ws + WS_GB), (bf16*)(ws + WS_MERGED)};
        pg8::gemm_phase<EpiMerge, pg8::StaticOrder, false>(lds, g, S, E, wave);
    }
    SEAM(PH_MERGE);
    if (IN(PH_OUT)) {
        pg8::Gemm g{(const bf16*)(ws + WS_MERGED), (const bf16*)(ws + WS_WOUT), 2048, 2048, 2048};
        pg8::StaticOrder S; S.init(MTOK, 2048, G, bx);
        EpiOut E{p.in[I_X], p.out, (bf16*)(ws + WS_HB), (float*)(ws + WS_SUMSQ)};
        pg8::gemm_phase<EpiOut, pg8::StaticOrder, false>(lds, g, S, E, wave);
        touch_range(ws + WS_WGU, (size_t)NGU * 2048 * 2, gw, NGW, LANE_);
    }
    SEAM(PH_OUT);
    if (IN(PH_FFN)) {
        pg8::Gemm g{(const bf16*)(ws + WS_HB), (const bf16*)(ws + WS_WGU), 2048, 2048, 2048};
        pg8::StaticOrder S; S.init(MTOK, NGU, G, bx);
        EpiFfn E{(const float*)(ws + WS_SUMSQ), (bf16*)(ws + WS_ACT)};
        pg8::gemm_phase<EpiFfn, pg8::StaticOrder, true>(lds, g, S, E, wave);
        if (G == 256 && bx >= 128) phase_ffn_weights<false>(p, lds, (bx - 128) * NWAVES + wave, 128 * NWAVES, wave, LANE_, 11264, 11264 + 5632);
    }
    SEAM(PH_FFN);
    if (IN(PH_DOWN)) {
        pg8::Gemm g{(const bf16*)(ws + WS_ACT), (const bf16*)(ws + WS_WD), DFF, DFF, DFF};
        pg8::StaticOrder S; S.init(MTOK, 2048, G, bx);
        EpiDown E{p.out, (const bf16*)(ws + WS_HB)};
        pg8::gemm_phase<EpiDown, pg8::StaticOrder, false>(lds, g, S, E, wave);
    }
#undef IN
#undef SEAM
#undef TID_
#undef LANE_
}

extern "C" void kernel_launch(void* const* d_in, const int* in_sizes, int n_in, void* d_out, int out_size, void* d_ws, size_t ws_size, hipStream_t stream) {
    static int grid = 0;
    if (grid == 0) {
        if (n_in != 23 || out_size != MTOK * DM || ws_size < WS_END) { fprintf(stderr, "kernel_launch: unexpected shapes / workspace (%d inputs, out %d, ws %zu < %zu)\n", n_in, out_size, ws_size, (size_t)WS_END); grid = -1; return; }
        int dev = 0, cus = 0;
        if (hipGetDevice(&dev) != hipSuccess || hipDeviceGetAttribute(&cus, hipDeviceAttributeMultiprocessorCount, dev) != hipSuccess) { grid = -1; return; }
        if (hipFuncSetAttribute((const void*)fwd, hipFuncAttributeMaxDynamicSharedMemorySize, LDS_BYTES) != hipSuccess) { fprintf(stderr, "kernel_launch: hipFuncSetAttribute failed\n"); grid = -1; return; }
        int per_cu = 0;
        if (hipOccupancyMaxActiveBlocksPerMultiprocessor(&per_cu, (const void*)fwd, NTHREADS, LDS_BYTES) != hipSuccess || per_cu < 1) { fprintf(stderr, "kernel_launch: occupancy query says %d blocks/CU\n", per_cu); grid = -1; return; }
        grid = cus;
    }
    if (grid < 0) return;
    (void)hipMemsetAsync((char*)d_ws + WS_CTL, 0, 32 * 1024, stream);
    Params p{};
    for (int i = 0; i < 23; ++i) p.in[i] = (const float*)d_in[i];
    p.out = (float*)d_out; p.ws = (unsigned char*)d_ws;
    p.ph_lo = 0; p.ph_hi = PH_N;
    void* args[] = {&p};
    hipError_t e = hipLaunchCooperativeKernel((const void*)fwd, dim3(grid), dim3(NTHREADS), args, LDS_BYTES, stream);
    if (e != hipSuccess) fprintf(stderr, "cooperative launch failed: %s (grid %d)\n", hipGetErrorString(e), grid);
}
```
